# Optimizing an MI355X kernel written in HIP

```python
import jax, jax.numpy as jnp
from jax import lax
import numpy as np

D_MODEL = 1024
BATCH = 4
SEQ = 8192
DEPTH = 1

D_MIX = D_MODEL
D_ATTN = D_MIX // 2
N_HEADS = 8
HEAD_DIM = D_ATTN // N_HEADS
N_IDX_HEADS = 8
IDX_DIM = 64
TOPK_MAX = 256
Q_BLOCK = 128
ROPE_THETA = 10000.0
D_POOL = D_MIX - D_ATTN
POOL_WINDOWS = (2, 4, 8, 16)
N_POOL_GROUPS = 4
POOL_GROUP_DIM = D_POOL // N_POOL_GROUPS
SPLIT_POINTS = (D_ATTN,
                D_ATTN + HEAD_DIM,
                D_ATTN + 2 * HEAD_DIM,
                D_ATTN + 2 * HEAD_DIM + N_IDX_HEADS * IDX_DIM,
                D_ATTN + 2 * HEAD_DIM + N_IDX_HEADS * IDX_DIM + IDX_DIM,
                D_ATTN + 2 * HEAD_DIM + N_IDX_HEADS * IDX_DIM + IDX_DIM + N_IDX_HEADS)
D_IN = SPLIT_POINTS[-1] + D_POOL
N_GROUPS = 4
EXPERTS_PER_GROUP = 8
N_EXPERTS = N_GROUPS * EXPERTS_PER_GROUP
TOP_K = 2
D_EXPERT = 256
EPS = 1e-6

kernel_name = "hymba_dsa_pool_hmoe_adaln"


def rms_norm(x, g):
    xf = x.astype(jnp.float32)
    y = xf * lax.rsqrt(jnp.mean(xf * xf, axis=-1, keepdims=True) + EPS)
    return (y * g.astype(jnp.float32)).astype(x.dtype)


def rope_tables(positions, dim):
    inv_freq = ROPE_THETA ** (-jnp.arange(0, dim, 2, dtype=jnp.float32) / dim)
    ang = positions.astype(jnp.float32)[..., None] * inv_freq
    return jnp.cos(ang), jnp.sin(ang)


def apply_rope(x, cos, sin):
    x1, x2 = jnp.split(x.astype(jnp.float32), 2, axis=-1)
    return jnp.concatenate([x1 * cos - x2 * sin, x1 * sin + x2 * cos], axis=-1).astype(x.dtype)


def dsa_attention(q, kv, q_idx, k_idx, w_idx):
    B, S = q.shape[0], q.shape[1]
    topk = min(TOPK_MAX, S // 4)
    n_blocks = S // Q_BLOCK
    key_pos = jnp.arange(S)

    def block(i):
        start = i * Q_BLOCK
        qb = lax.dynamic_slice_in_dim(q, start, Q_BLOCK, axis=1)
        qib = lax.dynamic_slice_in_dim(q_idx, start, Q_BLOCK, axis=1)
        wb = lax.dynamic_slice_in_dim(w_idx, start, Q_BLOCK, axis=1)
        s_idx = jnp.einsum('bqhd,bsd->bqhs', qib, k_idx, preferred_element_type=jnp.float32)
        score = jnp.einsum('bqh,bqhs->bqs', wb, jax.nn.relu(s_idx))
        q_pos = start + jnp.arange(Q_BLOCK)
        causal = key_pos[None, :] <= q_pos[:, None]
        score = jnp.where(causal[None], score, -jnp.inf)
        top_val, top_ind = lax.top_k(score, topk)
        valid = top_val > -jnp.inf
        kv_sel = jax.vmap(lambda kvb, ib: kvb[ib])(kv, top_ind)
        k_sel, v_sel = jnp.split(kv_sel, 2, axis=-1)
        logits = jnp.einsum('bqhd,bqkd->bqhk', qb, k_sel,
                            preferred_element_type=jnp.float32) * (HEAD_DIM ** -0.5)
        logits = jnp.where(valid[:, :, None, :], logits, -jnp.inf)
        p = jax.nn.softmax(logits, axis=-1).astype(v_sel.dtype)
        return jnp.einsum('bqhk,bqkd->bqhd', p, v_sel)

    out = lax.map(block, jnp.arange(n_blocks))
    return jnp.moveaxis(out, 0, 1).reshape(B, S, N_HEADS * HEAD_DIM)


def pool_mixer(u, w_pool, pool_scale):
    B, S, _ = u.shape
    ug = u.reshape(B, S, N_POOL_GROUPS, POOL_GROUP_DIM)
    cs = jnp.cumsum(ug.astype(jnp.float32), axis=1)
    t = jnp.arange(S)
    outs = []
    for g, win in enumerate(POOL_WINDOWS):
        cg = cs[:, :, g]
        c_shift = jnp.pad(cg, ((0, 0), (win, 0), (0, 0)))[:, :S]
        cnt = jnp.minimum(t + 1, win).astype(jnp.float32)[None, :, None]
        outs.append((cg - c_shift) / cnt - ug[:, :, g].astype(jnp.float32))
    pooled = jnp.stack(outs, axis=2).astype(u.dtype)
    mixed = jnp.einsum('bsgc,gcd->bsgd', pooled, w_pool)
    return mixed.reshape(B, S, D_POOL) * pool_scale


def hierarchical_moe(h, w_rg, b_rg, w_re, b_re, w_gate, w_up, w_down):
    B, S, D = h.shape
    ht = h.reshape(B * S, D)
    g_logits = (ht @ w_rg + b_rg).astype(jnp.float32)
    p_group = jax.nn.softmax(g_logits, axis=-1)
    g_sel = jnp.argmax(g_logits, axis=-1)
    p_g = jnp.take_along_axis(p_group, g_sel[:, None], axis=-1)
    e_logits = (ht @ w_re + b_re).astype(jnp.float32).reshape(-1, N_GROUPS, EXPERTS_PER_GROUP)
    e_logits = jnp.take_along_axis(e_logits, g_sel[:, None, None], axis=1)[:, 0]
    p_e = jax.nn.softmax(e_logits, axis=-1)
    top_p, top_e = lax.top_k(p_e, TOP_K)
    top_p = top_p / jnp.sum(top_p, axis=-1, keepdims=True)
    flat = g_sel[:, None] * EXPERTS_PER_GROUP + top_e
    gates = jnp.sum(jax.nn.one_hot(flat, N_EXPERTS, dtype=jnp.float32)
                    * (p_g * top_p)[..., None], axis=1).astype(h.dtype)
    y = jnp.zeros_like(ht)
    for e in range(N_EXPERTS):
        a = jax.nn.silu(ht @ w_gate[e]) * (ht @ w_up[e])
        y = y + gates[:, e:e + 1] * (a @ w_down[e])
    return y.reshape(B, S, D)


def setup_inputs(seed: int = 0) -> dict:
    key = jax.random.key(seed)
    ks = jax.random.split(key, 22)
    f32 = jnp.float32
    nrm = lambda k, shape, s: jax.random.normal(k, shape, f32) * s
    x = jax.random.normal(ks[0], (BATCH, SEQ, D_MODEL), f32)
    c = jax.random.normal(ks[1], (BATCH, D_MODEL), f32)
    offset = jax.random.randint(ks[2], (BATCH, 1), 0, 4096, dtype=jnp.int32)
    positions = (offset + jnp.arange(SEQ, dtype=jnp.int32)[None, :]).astype(jnp.int32)
    return {
        "x": x,
        "c": c,
        "positions": positions,
        "w_ada": nrm(ks[3], (DEPTH, D_MODEL, 6 * D_MODEL), 0.5 * D_MODEL ** -0.5),
        "b_ada": nrm(ks[4], (DEPTH, 6 * D_MODEL), 0.02),
        "g_norm_mix": 1.0 + nrm(ks[5], (DEPTH, D_MODEL), 0.1),
        "g_norm_ffn": 1.0 + nrm(ks[6], (DEPTH, D_MODEL), 0.1),
        "w_in": nrm(ks[7], (DEPTH, D_MODEL, D_IN), D_MODEL ** -0.5),
        "g_q": 1.0 + nrm(ks[8], (DEPTH, HEAD_DIM), 0.1),
        "g_k": 1.0 + nrm(ks[9], (DEPTH, HEAD_DIM), 0.1),
        "g_kidx": 1.0 + nrm(ks[10], (DEPTH, IDX_DIM), 0.1),
        "w_pool": nrm(ks[11], (DEPTH, N_POOL_GROUPS, POOL_GROUP_DIM, POOL_GROUP_DIM), POOL_GROUP_DIM ** -0.5),
        "pool_scale": 0.5 + nrm(ks[12], (DEPTH, D_POOL), 0.1),
        "w_out": nrm(ks[13], (DEPTH, D_MIX, D_MODEL), D_MIX ** -0.5),
        "w_router_group": nrm(ks[14], (DEPTH, D_MODEL, N_GROUPS), D_MODEL ** -0.5),
        "b_router_group": nrm(ks[15], (DEPTH, N_GROUPS), 0.01),
        "w_router_expert": nrm(ks[16], (DEPTH, D_MODEL, N_EXPERTS), D_MODEL ** -0.5),
        "b_router_expert": nrm(ks[17], (DEPTH, N_EXPERTS), 0.01),
        "w_gate": nrm(ks[18], (DEPTH, N_EXPERTS, D_MODEL, D_EXPERT), D_MODEL ** -0.5),
        "w_up": nrm(ks[19], (DEPTH, N_EXPERTS, D_MODEL, D_EXPERT), D_MODEL ** -0.5),
        "w_down": nrm(ks[20], (DEPTH, N_EXPERTS, D_EXPERT, D_MODEL), D_EXPERT ** -0.5),
    }


def reference(x, c, positions, w_ada, b_ada, g_norm_mix, g_norm_ffn, w_in, g_q, g_k, g_kidx,
              w_pool, pool_scale, w_out, w_router_group, b_router_group, w_router_expert,
              b_router_expert, w_gate, w_up, w_down):
    B, S, D = x.shape
    cos, sin = rope_tables(positions, HEAD_DIM)
    cos_h, sin_h = cos[:, :, None, :], sin[:, :, None, :]
    c_act = jax.nn.silu(c)
    for l in range(DEPTH):
        mod = c_act @ w_ada[l] + b_ada[l]
        shift1, scale1, gate1, shift2, scale2, gate2 = [m[:, None, :] for m in jnp.split(mod, 6, axis=-1)]

        h = rms_norm(x, g_norm_mix[l]) * (1.0 + scale1) + shift1
        proj = h @ w_in[l]
        q, k, v, q_idx, k_idx, w_idx, u = jnp.split(proj, SPLIT_POINTS, axis=-1)
        q = apply_rope(rms_norm(q.reshape(B, S, N_HEADS, HEAD_DIM), g_q[l]), cos_h, sin_h)
        k = apply_rope(rms_norm(k, g_k[l]), cos, sin)
        kv = jnp.concatenate([k, v], axis=-1)
        q_idx = apply_rope(q_idx.reshape(B, S, N_IDX_HEADS, IDX_DIM), cos_h, sin_h)
        k_idx = apply_rope(rms_norm(k_idx, g_kidx[l]), cos, sin)
        w_idx = w_idx.astype(jnp.float32) * (N_IDX_HEADS ** -0.5 * IDX_DIM ** -0.5)
        attn_out = dsa_attention(q, kv, q_idx, k_idx, w_idx)
        pool_out = pool_mixer(u, w_pool[l], pool_scale[l])
        mix = jnp.concatenate([attn_out, pool_out], axis=-1) @ w_out[l]
        x = x + gate1 * mix

        h2 = rms_norm(x, g_norm_ffn[l]) * (1.0 + scale2) + shift2
        x = x + gate2 * hierarchical_moe(h2, w_router_group[l], b_router_group[l],
                                         w_router_expert[l], b_router_expert[l],
                                         w_gate[l], w_up[l], w_down[l])
    return x
```

```cpp
#include <hip/hip_runtime.h>
#include <cstdio>
#include <cstdint>

#ifndef N_LAUNCH_MODE
#define N_LAUNCH_MODE 1
#endif

#ifndef REP_MASK
#define REP_MASK 0
#endif
#define NREP(k) (((REP_MASK >> (k)) & 1) ? 2 : 1)
#define LAS __attribute__((address_space(3)))
typedef _Float16 f16;
typedef _Float16 f16x8 __attribute__((ext_vector_type(8)));
typedef _Float16 f16x4 __attribute__((ext_vector_type(4)));
typedef float f32x4 __attribute__((ext_vector_type(4)));
typedef float f32x16 __attribute__((ext_vector_type(16)));
typedef unsigned short u16;

constexpr int NB = 4, SEQ = 8192, DM = 1024, NT = NB * SEQ;
constexpr int DIN = 1736, NIN = 1792;
constexpr int NEXP = 32, DEXP = 256;
constexpr int TOPK = 256;
constexpr int NPH = 9;
constexpr float EPSN = 1e-6f;
constexpr int MOE_ROWS = 65536 + 32 * 256;

constexpr size_t WS_CTL = 0;
constexpr size_t CTL_BYTES = 65536;
constexpr size_t WS_MODP = WS_CTL + CTL_BYTES;
constexpr size_t WS_MOD = WS_MODP + 16ull * 4 * 6144 * 4;
constexpr size_t WS_WRT = WS_MOD + 4ull * 6144 * 4;
constexpr size_t WS_G3 = WS_WRT + 48ull * 1024 * 4;
constexpr size_t WS_WRH = WS_G3 + 1024;
constexpr size_t WS_WRL = WS_WRH + 48ull * 1024 * 2;
constexpr size_t WS_COS = WS_WRL + 48ull * 1024 * 2;
constexpr size_t WS_SIN = WS_COS + (size_t)NT * 32 * 4;
constexpr size_t WS_BTIN = WS_SIN + (size_t)NT * 32 * 4;
constexpr size_t WS_BTOUT = WS_BTIN + (size_t)NIN * DM * 2;
constexpr size_t WS_BT1 = WS_BTOUT + (size_t)DM * DM * 2;
constexpr size_t WS_BT2 = WS_BT1 + (size_t)NEXP * 512 * DM * 2;
constexpr size_t WS_H = WS_BT2 + (size_t)NEXP * DM * DEXP * 2;
constexpr size_t WS_Q = WS_H + (size_t)NT * DM * 2;
constexpr size_t WS_QI = WS_Q + (size_t)NT * 512 * 2;
constexpr size_t WS_U = WS_QI + (size_t)NT * 512 * 2;
constexpr size_t WS_KV = WS_U + (size_t)NT * 512 * 2;
constexpr size_t WS_KI = WS_KV + (size_t)NT * 128 * 2;
constexpr size_t WS_WI = WS_KI + (size_t)NT * 64 * 2;
constexpr size_t WS_AO = WS_WI + (size_t)NT * 8 * 4;
constexpr size_t WS_TOKROW = WS_AO + (size_t)NT * DM * 2;
constexpr size_t WS_LISTT = WS_TOKROW + (size_t)NT * 2 * 4;
constexpr size_t WS_LISTC = WS_LISTT + (size_t)NEXP * NT * 4;
constexpr size_t WS_X1H = WS_LISTC + (size_t)NEXP * NT * 4;
constexpr size_t WS_END = WS_X1H + (size_t)NT * DM * 2;
constexpr size_t WS_Y = WS_H;
constexpr size_t WS_ACT = WS_AO;
static_assert((size_t)MOE_ROWS * DM * 2 <= WS_KV - WS_H, "Y overlay");
static_assert((size_t)MOE_ROWS * DEXP * 2 <= (size_t)NT * DM * 2, "ACT overlay");
constexpr int CW_BAR = 0;
constexpr int CW_CNT = 4096;
constexpr int CW_P3Q = 4352;

constexpr int LDS_BYTES = 163840;
constexpr int LDS_MISC = LDS_BYTES - 1024;

#define XB_TMO      128
#define XB_XCNT(j)  (256  + 64 * (j))
#define XB_XSUB(j)  (1280 + 64 * (j))
#define XB_XGEN(j)  (2304 + 64 * (j))
#define XB_TOP      3328
#define XB_TOPGEN   3392
#define XCD_BAR_WORDS 3456
#define XB_SPIN_CAP (1u << 18)
__device__ __forceinline__ unsigned xb_ld(unsigned* p)              { return __hip_atomic_load(p, __ATOMIC_RELAXED, __HIP_MEMORY_SCOPE_AGENT); }
__device__ __forceinline__ unsigned xb_add(unsigned* p, unsigned v) { return __hip_atomic_fetch_add(p, v, __ATOMIC_RELAXED, __HIP_MEMORY_SCOPE_AGENT); }
__device__ __forceinline__ unsigned xb_xcc_id() { return (unsigned)__builtin_amdgcn_s_getreg((3 << 11) | 20) & 0xFu; }
#define XB_SPIN(cond, bar) do { unsigned _sp = 0; while (cond) { __builtin_amdgcn_s_sleep(1); \
    if ((++_sp & 255u) == 0u) { if (xb_ld(&(bar)[XB_TMO])) break; if (_sp > XB_SPIN_CAP) { atomicAdd(&(bar)[XB_TMO], 1u); break; } } } } while (0)
struct XcdBarrier { unsigned* bar; unsigned x; volatile LAS unsigned* st; };
__device__ __forceinline__ XcdBarrier xcd_barrier_post(unsigned* bar, volatile LAS unsigned* st) {
    XcdBarrier b; b.bar = bar; b.x = xb_xcc_id(); b.st = st;
    if (threadIdx.x == 0) (void)xb_add(&bar[XB_XCNT(b.x)], 1u);
    return b;
}
__device__ __forceinline__ void xcd_barrier_complete(unsigned* bar, unsigned x, unsigned& nloc, unsigned& nx) {
    const unsigned G = gridDim.x * gridDim.y * gridDim.z;
    unsigned sum, cnt, mine, sp = 0u;
    for (;;) {
        sum = 0u; cnt = 0u; mine = 0u;
#pragma unroll
        for (unsigned j = 0; j < 16; ++j) { const unsigned c = xb_ld(&bar[XB_XCNT(j)]); sum += c; cnt += (c > 0u) ? 1u : 0u; mine = (j == x) ? c : mine; }
        if (sum == G) break;
        __builtin_amdgcn_s_sleep(1);
        if ((++sp & 255u) == 0u) { if (xb_ld(&bar[XB_TMO])) break; if (sp > XB_SPIN_CAP) { atomicAdd(&bar[XB_TMO], 1u); break; } }
    }
    nloc = mine > 0u ? mine : 1u; nx = cnt > 0u ? cnt : 1u;
}
__device__ __forceinline__ void xcd_barrier(const XcdBarrier& b) {
    asm volatile("s_waitcnt vmcnt(0)" ::: "memory");
    __syncthreads();
    if (threadIdx.x == 0) {
        unsigned* bar = b.bar;
        __builtin_amdgcn_s_waitcnt(0);
        unsigned nloc = b.st[0], nx = b.st[1];
        if (nloc == 0u) { xcd_barrier_complete(bar, b.x, nloc, nx); b.st[0] = nloc; b.st[1] = nx; }
        const unsigned old = xb_add(&bar[XB_XSUB(b.x)], 1u);
        const unsigned gen = old / nloc;
        if (old + 1u == (gen + 1u) * nloc) {
            __builtin_amdgcn_fence(__ATOMIC_RELEASE, "agent");
            asm volatile("s_waitcnt vmcnt(0)" ::: "memory");
            const unsigned og = xb_add(&bar[XB_TOP], 1u);
            const unsigned tg = og / nx;
            if (og + 1u == (tg + 1u) * nx) xb_add(&bar[XB_TOPGEN], 1u);
            else XB_SPIN(xb_ld(&bar[XB_TOPGEN]) == tg, bar);
            __builtin_amdgcn_fence(__ATOMIC_ACQUIRE, "agent");
            xb_add(&bar[XB_XGEN(b.x)], 1u);
            asm volatile("s_waitcnt vmcnt(0)" ::: "memory");
        } else {
            XB_SPIN(xb_ld(&bar[XB_XGEN(b.x)]) == gen, bar);
            __builtin_amdgcn_fence(__ATOMIC_ACQUIRE, "agent");
            asm volatile("s_waitcnt vmcnt(0)" ::: "memory");
        }
    }
    __syncthreads();
}

struct Args {
    const float* x; const float* c; const int* pos; const float* w_ada; const float* b_ada; const float* g_mix; const float* g_ffn; const float* w_in;
    const float* g_q; const float* g_k; const float* g_kidx; const float* w_pool; const float* pool_scale; const float* w_out;
    const float* w_rg; const float* b_rg; const float* w_re; const float* b_re; const float* w_gate; const float* w_up; const float* w_down;
    float* out; unsigned char* ws; int ph_lo, ph_hi;
};
struct Frame {
    LAS unsigned char* lds; int tid, lane, wave, G;
    unsigned char* ws;
};
#define FPTR(type, off) ((type*)(F.ws + (off)))

#define DPP_I(v, ctrl, rmask, oldv) __builtin_amdgcn_update_dpp((int)(oldv), (int)(v), (ctrl), (rmask), 0xf, false)
__device__ __forceinline__ float wave_sum(float v) {
    v += __int_as_float(DPP_I(__float_as_int(v), 0x111, 0xf, 0)); v += __int_as_float(DPP_I(__float_as_int(v), 0x112, 0xf, 0));
    v += __int_as_float(DPP_I(__float_as_int(v), 0x114, 0xf, 0)); v += __int_as_float(DPP_I(__float_as_int(v), 0x118, 0xf, 0));
    v += __int_as_float(DPP_I(__float_as_int(v), 0x142, 0xa, 0)); v += __int_as_float(DPP_I(__float_as_int(v), 0x143, 0xc, 0));
    return __int_as_float(__builtin_amdgcn_readlane(__float_as_int(v), 63));
}
__device__ __forceinline__ unsigned wave_min_u(unsigned v) {
    unsigned t;
    t = (unsigned)DPP_I(v, 0x111, 0xf, 0xFFFFFFFFu); v = t < v ? t : v; t = (unsigned)DPP_I(v, 0x112, 0xf, 0xFFFFFFFFu); v = t < v ? t : v;
    t = (unsigned)DPP_I(v, 0x114, 0xf, 0xFFFFFFFFu); v = t < v ? t : v; t = (unsigned)DPP_I(v, 0x118, 0xf, 0xFFFFFFFFu); v = t < v ? t : v;
    t = (unsigned)DPP_I(v, 0x142, 0xa, 0xFFFFFFFFu); v = t < v ? t : v; t = (unsigned)DPP_I(v, 0x143, 0xc, 0xFFFFFFFFu); v = t < v ? t : v;
    return (unsigned)__builtin_amdgcn_readlane((int)v, 63);
}
__device__ __forceinline__ unsigned wave_max_u(unsigned v) {
    unsigned t;
    t = (unsigned)DPP_I(v, 0x111, 0xf, 0u); v = t > v ? t : v; t = (unsigned)DPP_I(v, 0x112, 0xf, 0u); v = t > v ? t : v;
    t = (unsigned)DPP_I(v, 0x114, 0xf, 0u); v = t > v ? t : v; t = (unsigned)DPP_I(v, 0x118, 0xf, 0u); v = t > v ? t : v;
    t = (unsigned)DPP_I(v, 0x142, 0xa, 0u); v = t > v ? t : v; t = (unsigned)DPP_I(v, 0x143, 0xc, 0u); v = t > v ? t : v;
    return (unsigned)__builtin_amdgcn_readlane((int)v, 63);
}
__device__ __forceinline__ float silu_f(float v) { return v / (1.f + __expf(-v)); }

namespace gm {
constexpr int BM = 256, BK = 64, HALF = 128, HTB = HALF * BK * 2, STAGE_BYTES = 8 * HTB;
__device__ __forceinline__ int lds_byte(int r, int c) { const int st = (r >> 4) * 2 + (c >> 5), rr = r & 15, cc = c & 31, ob = rr * 64 + cc * 2; return st * 1024 + (ob ^ (((ob >> 9) & 1) << 5)); }
__device__ __forceinline__ void stage_rc(int b, int& R, int& C) { const int st = b / 1024, sb = b % 1024, swz = sb ^ (((sb >> 9) & 1) << 5); R = (st >> 1) * 16 + swz / 64; C = (st & 1) * 32 + (swz % 64) / 2; }

template <class Epi, class Sched, bool ALIGN_EPI>
__device__ __forceinline__ void gemm_phase(LAS unsigned char* lds, const char* Abase, const int K, const Sched& S, const Epi& E) {
    const int tid = threadIdx.x, wid = __builtin_amdgcn_readfirstlane(tid >> 6), lane = tid & 63, wr = wid >> 2, wc = wid & 3, fr = lane & 15, fq = lane >> 4;
    const int nt = K / BK;
    int Rr[2]; unsigned cbA[2], voffB[2];
#pragma unroll
    for (int i = 0; i < 2; ++i) { int R, C; stage_rc(tid * 16 + i * 8192, R, C); Rr[i] = R; cbA[i] = (unsigned)C * 2u; voffB[i] = (unsigned)(R * K + C) * 2u; }
    const size_t kstep = (size_t)(BK * 2);
    const size_t hstep = (size_t)HALF * K * 2;
    const unsigned rowb = (unsigned)K * 2u;
    const unsigned ldsw = (unsigned)wid * 1024u;
    LAS unsigned char* rowl = lds + 8 * HTB + wid * 1024;
    const int aoff = lds_byte(wr * 64 + fr, fq * 8), boff = lds_byte(wc * 32 + fr, fq * 8);
#define GM_SA(b, h) (((b) * 2 + (h)) * HTB)
#define GM_SB(b, h) ((4 + (b) * 2 + (h)) * HTB)
#define GM_STAGE(bufoff, gbase, voff) do { _Pragma("unroll") for (int _i = 0; _i < 2; ++_i) \
        __builtin_amdgcn_global_load_lds((const unsigned*)((const char*)(gbase) + (voff)[_i]), (LAS unsigned*)(lds + (bufoff) + ldsw + _i * 8192), 16, 0, 0); } while (0)
#define GM_LDA(dst, b, h) do { _Pragma("unroll") for (int m = 0; m < 4; ++m) _Pragma("unroll") for (int k = 0; k < 2; ++k) dst[m][k] = *(const LAS f16x8*)(lds + GM_SA(b, h) + aoff + m * 2048 + k * 1024); } while (0)
#define GM_LDB(dst, b, h) do { _Pragma("unroll") for (int n = 0; n < 2; ++n) _Pragma("unroll") for (int k = 0; k < 2; ++k) dst[n][k] = *(const LAS f16x8*)(lds + GM_SB(b, h) + boff + n * 2048 + k * 1024); } while (0)
#define GM_MMA(ai, bj, At, Bt) do { __builtin_amdgcn_s_setprio(1); _Pragma("unroll") for (int m = 0; m < 4; ++m) _Pragma("unroll") for (int n = 0; n < 2; ++n) _Pragma("unroll") for (int k = 0; k < 2; ++k) \
        acc[ai][bj][m][n] = __builtin_amdgcn_mfma_f32_16x16x32_f16(Bt[n][k], At[m][k], acc[ai][bj][m][n], 0, 0, 0); __builtin_amdgcn_s_setprio(0); } while (0)
#define GM_WAIT_V(n) asm volatile("s_waitcnt vmcnt(" #n ")" ::: "memory")
#define GM_WAIT_L(n) asm volatile("s_waitcnt lgkmcnt(" #n ")" ::: "memory")
#define GM_BAR __builtin_amdgcn_s_barrier()
#define GM_SCHED __builtin_amdgcn_sched_barrier(0)
    typename Sched::Unit cur, nxt; int ui = 0;
    if (!S.next(0, cur)) return;
    f32x4 acc[2][2][4][2];
#pragma unroll
    for (int a = 0; a < 2; ++a)
#pragma unroll
        for (int b = 0; b < 2; ++b)
#pragma unroll
            for (int m = 0; m < 4; ++m)
#pragma unroll
                for (int n = 0; n < 2; ++n) acc[a][b][m][n] = (f32x4){0.f, 0.f, 0.f, 0.f};
    f16x8 At[4][2], B0[2][2], B1[2][2];
    constexpr bool GA = Sched::GATHER;
    unsigned vA0[2], vA1[2], vN0[2], vN1[2];
    const char* cA = Abase;
    if constexpr (GA) {
#pragma unroll
        for (int i = 0; i < 2; ++i) { vA0[i] = S.arow(cur, Rr[i]) * rowb + cbA[i]; vA1[i] = S.arow(cur, HALF + Rr[i]) * rowb + cbA[i]; vN0[i] = vA0[i]; vN1[i] = vA1[i]; }
    } else {
#pragma unroll
        for (int i = 0; i < 2; ++i) { vA0[i] = (unsigned)Rr[i] * rowb + cbA[i]; vA1[i] = 0; vN0[i] = 0; vN1[i] = 0; }
        cA = Abase + S.abase(cur);
    }
#define GM_STAGE_A0(bufoff, ptr, o0) GM_STAGE(bufoff, ptr, o0)
#define GM_STAGE_A1(bufoff, ptr, o0, o1) do { if constexpr (GA) { GM_STAGE(bufoff, ptr, o1); } else { GM_STAGE(bufoff, (ptr) + hstep, o0); } } while (0)
    const char* cB = S.bptr(cur);
    GM_STAGE(GM_SB(0, 0), cB, voffB); GM_STAGE(GM_SB(0, 1), cB + hstep, voffB); GM_STAGE_A0(GM_SA(0, 0), cA, vA0); GM_STAGE_A1(GM_SA(0, 1), cA, vA0, vA1);
    if (wr == 1) GM_BAR;
    GM_WAIT_V(2); GM_BAR;
    GM_STAGE(GM_SB(1, 0), cB + kstep, voffB); GM_STAGE_A0(GM_SA(1, 0), cA + kstep, vA0); GM_STAGE(GM_SB(1, 1), cB + hstep + kstep, voffB);
    GM_WAIT_V(6); GM_BAR;
    for (;;) {
        const bool has_next = S.next(ui + 1, nxt);
        const char* nB = cB; const char* nA = cA;
        if constexpr (GA) {
#pragma unroll
            for (int i = 0; i < 2; ++i) { vN0[i] = vA0[i]; vN1[i] = vA1[i]; }
        }
        if (has_next) {
            nB = S.bptr(nxt);
            if constexpr (GA) {
#pragma unroll
                for (int i = 0; i < 2; ++i) {
                    __builtin_amdgcn_global_load_lds((const unsigned*)S.arowp(nxt, Rr[i]), (LAS unsigned*)(rowl + (2 * i) * 256), 4, 0, 0);
                    __builtin_amdgcn_global_load_lds((const unsigned*)S.arowp(nxt, HALF + Rr[i]), (LAS unsigned*)(rowl + (2 * i + 1) * 256), 4, 0, 0);
                }
            } else nA = Abase + S.abase(nxt);
        }
        for (int t = 0; t < nt; t += 2) {
            const bool last = (t == nt - 2);
            if constexpr (GA) {
                if (last && has_next) {
#pragma unroll
                    for (int i = 0; i < 2; ++i) { vN0[i] = *(const LAS unsigned*)(rowl + (2 * i) * 256 + lane * 4) * rowb + cbA[i]; vN1[i] = *(const LAS unsigned*)(rowl + (2 * i + 1) * 256 + lane * 4) * rowb + cbA[i]; }
                }
            }
            const char* a1 = cA + (size_t)(t + 1) * kstep;
            const char* a2 = last ? nA : cA + (size_t)(t + 2) * kstep; const char* b2 = last ? nB : cB + (size_t)(t + 2) * kstep;
            const char* a3 = a2 + kstep; const char* b3 = b2 + kstep;
            unsigned w0[2], w1[2];
#pragma unroll
            for (int i = 0; i < 2; ++i) { w0[i] = (GA && last) ? vN0[i] : vA0[i]; w1[i] = (GA && last) ? vN1[i] : vA1[i]; }
            GM_LDB(B0, 0, 0); GM_LDB(B1, 0, 1); GM_SCHED; GM_LDA(At, 0, 0); GM_STAGE_A1(GM_SA(1, 1), a1, vA0, vA1);
            GM_WAIT_V(8); GM_WAIT_L(0); GM_BAR; GM_MMA(0, 0, At, B0); GM_MMA(0, 1, At, B1); GM_BAR; GM_SCHED;
            GM_LDA(At, 0, 1); GM_STAGE(GM_SB(0, 0), b2, voffB); GM_STAGE(GM_SB(0, 1), b2 + hstep, voffB); GM_STAGE_A0(GM_SA(0, 0), a2, w0);
            GM_WAIT_V(8); GM_WAIT_L(0); GM_BAR; GM_MMA(1, 0, At, B0); GM_MMA(1, 1, At, B1); GM_BAR; GM_SCHED;
            GM_LDB(B0, 1, 0); GM_LDB(B1, 1, 1); GM_SCHED; GM_LDA(At, 1, 0); GM_STAGE_A1(GM_SA(0, 1), a2, w0, w1);
            GM_WAIT_V(8); GM_WAIT_L(0); GM_BAR; GM_MMA(0, 0, At, B0); GM_MMA(0, 1, At, B1); GM_BAR; GM_SCHED;
            GM_LDA(At, 1, 1); GM_STAGE(GM_SB(1, 0), b3, voffB); GM_STAGE(GM_SB(1, 1), b3 + hstep, voffB); GM_STAGE_A0(GM_SA(1, 0), a3, w0);
            GM_WAIT_V(8); GM_WAIT_L(0); GM_BAR; GM_MMA(1, 0, At, B0); GM_MMA(1, 1, At, B1); GM_BAR; GM_SCHED;
        }
        if constexpr (ALIGN_EPI) { if (wr == 0) GM_BAR; }
        E(acc, cur, wr, wc, fr, fq);
        if (!has_next) break;
#pragma unroll
        for (int a = 0; a < 2; ++a)
#pragma unroll
            for (int b = 0; b < 2; ++b)
#pragma unroll
                for (int m = 0; m < 4; ++m)
#pragma unroll
                    for (int n = 0; n < 2; ++n) acc[a][b][m][n] = (f32x4){0.f, 0.f, 0.f, 0.f};
        cur = nxt; cB = nB; cA = nA; ++ui;
        if constexpr (GA) {
#pragma unroll
            for (int i = 0; i < 2; ++i) { vA0[i] = vN0[i]; vA1[i] = vN1[i]; }
        }
        if constexpr (ALIGN_EPI) { if (wr == 1) GM_BAR; }
    }
    GM_WAIT_V(0);
    if constexpr (!ALIGN_EPI) { if (wr == 0) GM_BAR; }
    GM_BAR;
#undef GM_SA
#undef GM_SB
#undef GM_STAGE
#undef GM_STAGE_A0
#undef GM_STAGE_A1
#undef GM_LDA
#undef GM_LDB
#undef GM_MMA
#undef GM_WAIT_V
#undef GM_WAIT_L
#undef GM_BAR
#undef GM_SCHED
}

struct DenseSched {
    static constexpr bool GATHER = false;
    struct Unit { int pm, pn; };
    int nM, nN, nwg, G, c, K; const char* Bt;
    __device__ void init(int M, int N, int K_, int G_, int c_, const void* Bt_) { nM = M / BM; nN = N / BM; nwg = nM * nN; G = G_; c = c_; K = K_; Bt = (const char*)Bt_; }
    __device__ __forceinline__ bool next(int i, Unit& u) const {
        const long L = (long)i * G + c; if (L >= nwg) return false;
        int wgid = (int)L; { const int q = nwg / 8, r = nwg % 8, xcd = wgid % 8, off = wgid / 8; wgid = (xcd < r ? xcd * (q + 1) : r * (q + 1) + (xcd - r) * q) + off; }
        const int nig = 8 * nN, gid = wgid / nig, fm = gid * 8, gsz = (nM - fm) < 8 ? (nM - fm) : 8;
        u.pm = fm + ((wgid % nig) % gsz); u.pn = (wgid % nig) / gsz; return true;
    }
    __device__ __forceinline__ unsigned arow(const Unit& u, int r) const { return (unsigned)(u.pm * BM + r); }
    __device__ __forceinline__ const int* arowp(const Unit&, int) const { return nullptr; }
    __device__ __forceinline__ size_t abase(const Unit& u) const { return (size_t)u.pm * BM * K * 2; }
    __device__ __forceinline__ const char* bptr(const Unit& u) const { return Bt + (size_t)u.pn * BM * K * 2; }
};
}

__device__ __forceinline__ int prow32(int c) { return (c & ~31) | (((c >> 2) & 1) << 4) | (((c >> 3) & 3) << 2) | (c & 3); }
__device__ __forceinline__ int colmap_in(int n) {
    const int pn = n >> 8, r = n & 255, bj = r >> 7, wc = (r >> 5) & 3, i = (((r >> 2) & 3) << 3) | (((r >> 4) & 1) << 2) | (r & 3);
    if (pn < 2) return (4 * pn + wc) * 64 + bj * 32 + i;
    if (pn < 4) return 640 + (4 * (pn - 2) + wc) * 64 + bj * 32 + i;
    if (pn == 4) {
        if (wc == 0) return 512 + bj * 32 + i;
        if (wc == 1) return 1152 + bj * 32 + i;
        if (wc == 2) return 576 + bj * 32 + i;
        return (bj == 0 && i < 8) ? 1216 + i : -1;
    }
    return 1224 + (pn - 5) * 256 + (r & ~31) + i;
}

template <class ColF>
__device__ __forceinline__ void transpose_tile(const Frame& F, const float* src, int lds_, f16* dst, int ldd, int k0, int n0, ColF colf) {
    LAS float* tile = (LAS float*)F.lds;
    const int n4 = (F.tid & 15) * 4, kq = F.tid >> 4;
    const int col = colf(n0 + n4);
#pragma unroll
    for (int rep = 0; rep < 2; ++rep) {
        const int kk = kq + 32 * rep;
        f32x4 v = {0.f, 0.f, 0.f, 0.f};
        if (col >= 0) v = *(const f32x4*)(src + (size_t)(k0 + kk) * lds_ + col);
#pragma unroll
        for (int e = 0; e < 4; ++e) tile[kk * 65 + n4 + e] = v[e];
    }
    __syncthreads();
    const int nr = F.tid >> 3, kc = (F.tid & 7) * 8;
    f16x8 o;
#pragma unroll
    for (int j = 0; j < 8; ++j) o[j] = (f16)tile[(kc + j) * 65 + nr];
    *(f16x8*)(dst + (size_t)(n0 + nr) * ldd + k0 + kc) = o;
    __syncthreads();
}

__device__ __forceinline__ void p0_prologue(const Frame& F, const Args& a) {
    const int gid = blockIdx.x * 512 + F.tid, gsz = F.G * 512;
    {
        LAS float* ca = (LAS float*)F.lds;
        for (int i = F.tid; i < 4096; i += 512) ca[i] = silu_f(a.c[i]);
        __syncthreads();
        for (int id = gid; id < 16 * 6144; id += gsz) {
            const int kc = id / 6144, n = id - kc * 6144;
            float s0 = 0.f, s1 = 0.f, s2 = 0.f, s3 = 0.f;
#pragma unroll 32
            for (int k = kc * 64; k < kc * 64 + 64; ++k) { const float w = a.w_ada[(size_t)k * 6144 + n]; s0 += ca[k] * w; s1 += ca[1024 + k] * w; s2 += ca[2048 + k] * w; s3 += ca[3072 + k] * w; }
            float* mp = FPTR(float, WS_MODP) + (size_t)kc * 4 * 6144 + n;
            mp[0] = s0; mp[6144] = s1; mp[2 * 6144] = s2; mp[3 * 6144] = s3;
        }
        __syncthreads();
    }
    {
        const float inv = (float)pow(10000.0, -(double)(2 * (gid & 31)) / 64.0);
        for (int id = gid; id < NT * 32; id += gsz) {
            const int t = id >> 5;
            const float ang = (float)a.pos[t] * inv;
            const double rev = (double)ang * 0.15915494309189535;
            const float fr = (float)(rev - rint(rev));
            FPTR(float, WS_COS)[id] = __builtin_amdgcn_cosf(fr); FPTR(float, WS_SIN)[id] = __builtin_amdgcn_sinf(fr);
        }
    }
    if (gid < 192) ((float*)(a.ws + WS_G3))[gid] = gid < 64 ? a.g_q[gid] : (gid < 128 ? a.g_k[gid - 64] : a.g_kidx[gid - 128]);
    for (int id = gid; id < 48 * 1024; id += gsz) { const int o = id >> 10, k = id & 1023; const float w = o < 4 ? a.w_rg[k * 4 + o] : (o < 36 ? a.w_re[k * 32 + (o - 4)] : 0.f);
        FPTR(float, WS_WRT)[id] = w; const f16 hi = (f16)w; FPTR(f16, WS_WRH)[id] = hi; FPTR(f16, WS_WRL)[id] = (f16)((w - (float)hi) * 2048.f); }
    constexpr int NT_FOLD = 256, NT_IN = 28 * 16, NT_OUT = 16 * 8, NT_G = 32 * 8 * 16, NT_D = 32 * 16 * 4;
    constexpr int NTASK = NT_FOLD + NT_IN + NT_OUT + NT_G + NT_D;
    for (int task = blockIdx.x; task < NTASK; task += F.G) {
        int tk = task;
        if (tk < NT_FOLD) {
            const int g = tk >> 6, cch = (tk >> 4) & 3, nb = tk & 15, n = nb * 64 + (F.tid & 63), cg = F.tid >> 6;
            LAS float* wps = (LAS float*)F.lds;
            for (int i = F.tid; i < 32 * 128; i += 512) wps[i] = a.w_pool[(size_t)(g * 128 + cch * 32) * 128 + i];
            if (F.tid < 128) wps[4096 + F.tid] = a.pool_scale[g * 128 + F.tid];
            __syncthreads();
            float accv[4] = {0.f, 0.f, 0.f, 0.f};
#pragma unroll 4
            for (int d = 0; d < 128; d += 4) {
                f32x4 wo; const f32x4 ps = *(const LAS f32x4*)(wps + 4096 + d);
#pragma unroll
                for (int e = 0; e < 4; ++e) wo[e] = a.w_out[(size_t)(512 + g * 128 + d + e) * DM + n] * ps[e];
#pragma unroll
                for (int c = 0; c < 4; ++c) { const f32x4 w4 = *(const LAS f32x4*)(wps + (cg * 4 + c) * 128 + d); accv[c] += w4[0] * wo[0] + w4[1] * wo[1] + w4[2] * wo[2] + w4[3] * wo[3]; }
            }
            __syncthreads();
            { f16x4 o;
#pragma unroll
              for (int c = 0; c < 4; ++c) o[c] = (f16)accv[c];
              *(f16x4*)(FPTR(f16, WS_BTOUT) + (size_t)prow32(n) * DM + 512 + g * 128 + cch * 32 + cg * 4) = o; }
            continue;
        }
        break;
    }
    {
        LAS float* tile = (LAS float*)F.lds;
        const int n4 = (F.tid & 15) * 4, kq = F.tid >> 4, nr = F.tid >> 3, kc = (F.tid & 7) * 8;
        struct TD { const float* src; f16* dst; int lds_, ldd, k0, n0, col, tc; };
        auto decode = [&](int task, TD& d) -> bool {
            int tk = task - NT_FOLD;
            if (tk < 0 || task >= NTASK) return false;
            if (tk < NT_IN) { d.src = a.w_in; d.lds_ = DIN; d.dst = FPTR(f16, WS_BTIN); d.ldd = DM; d.k0 = (tk & 15) * 64; d.n0 = (tk >> 4) * 64; d.col = colmap_in(d.n0 + n4); d.tc = n4; return true; }
            tk -= NT_IN;
            if (tk < NT_OUT) { d.src = a.w_out; d.lds_ = DM; d.dst = FPTR(f16, WS_BTOUT); d.ldd = DM; d.k0 = (tk & 7) * 64; d.n0 = (tk >> 3) * 64; d.col = d.n0 + n4; d.tc = prow32(n4); return true; }
            tk -= NT_OUT;
            if (tk < NT_G) {
                const int e = tk >> 7, r0 = ((tk >> 4) & 7) * 64, bj = (r0 & 255) >> 7;
                d.src = (bj ? a.w_up : a.w_gate) + (size_t)e * DM * DEXP; d.lds_ = DEXP; d.dst = FPTR(f16, WS_BT1) + (size_t)e * 512 * DM; d.ldd = DM; d.k0 = (tk & 15) * 64; d.n0 = r0;
                d.col = (r0 >> 8) * 128 + (r0 & 127) + n4; d.tc = prow32(n4); return true; }
            tk -= NT_G;
            { const int e = tk >> 6; d.src = a.w_down + (size_t)e * DEXP * DM; d.lds_ = DM; d.dst = FPTR(f16, WS_BT2) + (size_t)e * DM * DEXP; d.ldd = DEXP; d.k0 = (tk & 3) * 64; d.n0 = ((tk >> 2) & 15) * 64; d.col = d.n0 + n4; d.tc = prow32(n4); }
            return true;
        };
        int task = blockIdx.x; while (task < NT_FOLD) task += F.G;
        TD cur; bool have = decode(task, cur);
        f32x4 v0 = {0.f, 0.f, 0.f, 0.f}, v1 = v0;
        if (have && cur.col >= 0) { v0 = *(const f32x4*)(cur.src + (size_t)(cur.k0 + kq) * cur.lds_ + cur.col); v1 = *(const f32x4*)(cur.src + (size_t)(cur.k0 + kq + 32) * cur.lds_ + cur.col); }
        while (have) {
            TD nxt; const bool hn = decode(task + F.G, nxt);
            f32x4 w0 = {0.f, 0.f, 0.f, 0.f}, w1 = w0;
            if (hn && nxt.col >= 0) { w0 = *(const f32x4*)(nxt.src + (size_t)(nxt.k0 + kq) * nxt.lds_ + nxt.col); w1 = *(const f32x4*)(nxt.src + (size_t)(nxt.k0 + kq + 32) * nxt.lds_ + nxt.col); }
#pragma unroll
            for (int e = 0; e < 4; ++e) { tile[kq * 65 + cur.tc + e] = v0[e]; tile[(kq + 32) * 65 + cur.tc + e] = v1[e]; }
            __syncthreads();
            f16x8 o;
#pragma unroll
            for (int j = 0; j < 8; ++j) o[j] = (f16)tile[(kc + j) * 65 + nr];
            *(f16x8*)(cur.dst + (size_t)(cur.n0 + nr) * cur.ldd + cur.k0 + kc) = o;
            __syncthreads();
            cur = nxt; have = hn; v0 = w0; v1 = w1; task += F.G;
        }
    }
}

__device__ __forceinline__ void p1_norm(const Frame& F, const Args& a) {
    LAS float* gs = (LAS float*)F.lds; LAS float* sh = gs + 1024;
    for (int id = blockIdx.x * 512 + F.tid; id < 4 * 6144; id += F.G * 512) {
        float s = a.b_ada[id % 6144];
#pragma unroll
        for (int kc = 0; kc < 16; ++kc) s += FPTR(float, WS_MODP)[(size_t)kc * 4 * 6144 + id];
        FPTR(float, WS_MOD)[id] = s;
    }
    int curb = -1;
    for (int rb = blockIdx.x; rb < NT / 128; rb += F.G) {
        const int b = (rb * 128) / SEQ;
        if (b != curb) {
            __syncthreads();
            for (int cidx = F.tid; cidx < 1024; cidx += 512) {
                float s1 = a.b_ada[cidx], s2 = a.b_ada[1024 + cidx];
#pragma unroll
                for (int kc = 0; kc < 16; ++kc) { s1 += FPTR(float, WS_MODP)[(size_t)(kc * 4 + b) * 6144 + cidx]; s2 += FPTR(float, WS_MODP)[(size_t)(kc * 4 + b) * 6144 + 1024 + cidx]; }
                sh[cidx] = s1; gs[cidx] = a.g_mix[cidx] * (1.f + s2);
            }
            __syncthreads();
            curb = b;
        }
        for (int rq = 0; rq < 4; ++rq) {
            f32x4 v[4][4]; float ss[4];
#pragma unroll
            for (int r = 0; r < 4; ++r) {
                const float* xr = a.x + ((size_t)rb * 128 + F.wave * 16 + rq * 4 + r) * DM;
                ss[r] = 0.f;
#pragma unroll
                for (int j = 0; j < 4; ++j) v[r][j] = *(const f32x4*)(xr + 256 * j + 4 * F.lane);
            }
#pragma unroll
            for (int r = 0; r < 4; ++r) {
#pragma unroll
                for (int j = 0; j < 4; ++j) ss[r] += v[r][j][0] * v[r][j][0] + v[r][j][1] * v[r][j][1] + v[r][j][2] * v[r][j][2] + v[r][j][3] * v[r][j][3];
                ss[r] = wave_sum(ss[r]);
            }
#pragma unroll
            for (int r = 0; r < 4; ++r) {
                const size_t t = (size_t)rb * 128 + F.wave * 16 + rq * 4 + r;
                const float rs = rsqrtf(ss[r] * (1.f / 1024.f) + EPSN);
#pragma unroll
                for (int j = 0; j < 4; ++j) {
                    const int c0 = 256 * j + 4 * F.lane; f16x4 o;
#pragma unroll
                    for (int e = 0; e < 4; ++e) o[e] = (f16)(v[r][j][e] * rs * gs[c0 + e] + sh[c0 + e]);
                    *(f16x4*)(FPTR(f16, WS_H) + t * DM + c0) = o;
                }
            }
        }
    }
}

struct EpiIn {
    unsigned char* ws;
    __device__ __forceinline__ void operator()(const f32x4 (&acc)[2][2][4][2], const gm::DenseSched::Unit& u, int wr, int wc, int fr, int fq) const {
        asm volatile("" : "+v"(fr), "+v"(fq));
        const int pn = u.pn;
        if (pn >= 5) {
#pragma unroll
            for (int ai = 0; ai < 2; ++ai)
#pragma unroll
                for (int m = 0; m < 4; ++m) {
                    const size_t t = (size_t)u.pm * 256 + ai * 128 + wr * 64 + m * 16 + fr;
#pragma unroll
                    for (int bj = 0; bj < 2; ++bj) { f16x8 o;
_Pragma("unroll") for (int n = 0; n < 2; ++n) _Pragma("unroll") for (int e = 0; e < 4; ++e) o[n * 4 + e] = (f16)acc[ai][bj][m][n][e];
                        *(f16x8*)((f16*)(ws + WS_U) + t * 512 + (pn - 5) * 256 + bj * 128 + wc * 32 + fq * 8) = o; }
                }
            return;
        }
        if (pn == 4 && wc >= 2) {
            if (wc == 2) {
#pragma unroll
                for (int ai = 0; ai < 2; ++ai)
#pragma unroll
                    for (int m = 0; m < 4; ++m) {
                        const size_t t = (size_t)u.pm * 256 + ai * 128 + wr * 64 + m * 16 + fr;
#pragma unroll
                        for (int bj = 0; bj < 2; ++bj) { f16x8 o;
_Pragma("unroll") for (int n = 0; n < 2; ++n) _Pragma("unroll") for (int e = 0; e < 4; ++e) o[n * 4 + e] = (f16)acc[ai][bj][m][n][e];
                            *(f16x8*)((f16*)(ws + WS_KV) + t * 128 + 64 + bj * 32 + fq * 8) = o; }
                    }
            } else if (fq == 0) {
#pragma unroll
                for (int ai = 0; ai < 2; ++ai)
#pragma unroll
                    for (int m = 0; m < 4; ++m) {
                        const size_t t = (size_t)u.pm * 256 + ai * 128 + wr * 64 + m * 16 + fr;
                        *(f32x4*)((float*)(ws + WS_WI) + t * 8) = acc[ai][0][m][0] * 0.044194173824159216f;
                        *(f32x4*)((float*)(ws + WS_WI) + t * 8 + 4) = acc[ai][0][m][1] * 0.044194173824159216f;
                    }
            }
            return;
        }
        const bool isq = pn < 2, isqi = (pn == 2 || pn == 3), isk = (pn == 4 && wc == 0);
        const float* gv = (const float*)(ws + WS_G3) + (isq ? 0 : (isk ? 64 : 128));
        const bool donorm = !isqi;
        const float oscale = isq ? 0.125f : 1.f;
        f32x4 g1[2], g2[2];
#pragma unroll
        for (int n = 0; n < 2; ++n) { g1[n] = *(const f32x4*)(gv + fq * 8 + n * 4) * oscale; g2[n] = *(const f32x4*)(gv + 32 + fq * 8 + n * 4) * oscale; }
        if (!donorm) {
#pragma unroll
            for (int n = 0; n < 2; ++n) { g1[n] = (f32x4){1.f, 1.f, 1.f, 1.f}; g2[n] = g1[n]; } }
        const size_t doff = isq ? WS_Q : (isqi ? WS_QI : (isk ? WS_KV : WS_KI));
        f16* dst = (f16*)(ws + doff);
        const int ld = (isq || isqi) ? 512 : (isk ? 128 : 64);
        const int hoff = isq ? (4 * pn + wc) * 64 : (isqi ? (4 * (pn - 2) + wc) * 64 : 0);
        const float* COSp = (const float*)(ws + WS_COS); const float* SINp = (const float*)(ws + WS_SIN);
#pragma unroll
        for (int ai = 0; ai < 2; ++ai) {
            f32x4 cs[4][2], sn[4][2];
#pragma unroll
            for (int m = 0; m < 4; ++m) {
                const size_t t = (size_t)u.pm * 256 + ai * 128 + wr * 64 + m * 16 + fr;
#pragma unroll
                for (int n = 0; n < 2; ++n) { cs[m][n] = *(const f32x4*)(COSp + t * 32 + fq * 8 + n * 4); sn[m][n] = *(const f32x4*)(SINp + t * 32 + fq * 8 + n * 4); }
            }
#pragma unroll
            for (int m = 0; m < 4; ++m) {
                const size_t t = (size_t)u.pm * 256 + ai * 128 + wr * 64 + m * 16 + fr;
                float rs = 1.f;
                if (donorm) {
                    float ss = 0.f;
#pragma unroll
                    for (int bj = 0; bj < 2; ++bj)
#pragma unroll
                        for (int n = 0; n < 2; ++n)
#pragma unroll
                            for (int e = 0; e < 4; ++e) ss += acc[ai][bj][m][n][e] * acc[ai][bj][m][n][e];
                    ss += __shfl_xor(ss, 16); ss += __shfl_xor(ss, 32);
                    rs = rsqrtf(ss * (1.f / 64.f) + EPSN);
                }
                f16x8 o1, o2;
#pragma unroll
                for (int n = 0; n < 2; ++n)
#pragma unroll
                    for (int e = 0; e < 4; ++e) {
                        const float y1 = acc[ai][0][m][n][e] * rs * g1[n][e], y2 = acc[ai][1][m][n][e] * rs * g2[n][e];
                        o1[n * 4 + e] = (f16)(y1 * cs[m][n][e] - y2 * sn[m][n][e]); o2[n * 4 + e] = (f16)(y1 * sn[m][n][e] + y2 * cs[m][n][e]);
                    }
                *(f16x8*)(dst + t * ld + hoff + fq * 8) = o1;
                *(f16x8*)(dst + t * ld + hoff + 32 + fq * 8) = o2;
            }
        }
    }
};

constexpr int CAP = 960;
constexpr int P3_RING = 32768;
constexpr int P3_QB = CAP * 4;
constexpr int P3_WAVE_LDS = 4 * P3_QB;
static_assert(P3_RING + 8 * P3_WAVE_LDS <= LDS_MISC, "P3 LDS");
static_assert(P3_QB >= 1024 + 2048, "a query buffer holds its final 256-word list plus a 2 KiB piece of the V staging");

__device__ __forceinline__ unsigned fkey(float f) { const unsigned u = __float_as_uint(f); return u ^ ((u >> 31) ? 0xFFFFFFFFu : 0x80000000u); }
__device__ __forceinline__ float fkey_inv(unsigned k) { const unsigned u = (k & 0x80000000u) ? (k ^ 0x80000000u) : ~k; return __uint_as_float(u); }
__device__ __forceinline__ unsigned pack_cand(float s, int key) { return (fkey(s) & 0xFFFFE000u) | (8191u - (unsigned)key); }
__device__ __forceinline__ float pack_floor(unsigned w) { return fkey_inv(w & 0xFFFFE000u); }
__device__ __forceinline__ int mbcnt64(unsigned long long m) { return __builtin_amdgcn_mbcnt_hi((unsigned)(m >> 32), __builtin_amdgcn_mbcnt_lo((unsigned)m, 0)); }

template <int NJ>
__device__ __forceinline__ unsigned select_exact_n(LAS unsigned* buf, const int n, const int K, const int lane) {
    unsigned uk[NJ];
    unsigned lmin = 0xFFFFFFFFu, lmax = 0u;
#pragma unroll
    for (int j = 0; j < NJ; ++j) {
        const int p = j * 64 + lane; const unsigned w = buf[p];
        uk[j] = p < n ? w : 0u;
        if (p < n) { lmin = w < lmin ? w : lmin; lmax = w > lmax ? w : lmax; }
    }
    const unsigned umin = wave_min_u(lmin), umax = wave_max_u(lmax);
    const int hb = 31 - __builtin_clz(umin ^ umax);
    unsigned T = (hb == 31) ? 0u : (umax & ~((2u << hb) - 1u));
    int cT = n;
    for (int bit = hb; bit >= 0 && cT != K; --bit) {
        const unsigned cand = T | (1u << bit);
        int c = 0;
#pragma unroll
        for (int j = 0; j < NJ; ++j) c += __builtin_popcountll(__ballot(uk[j] >= cand));
        if (c >= K) { T = cand; cT = c; }
    }
    int wbase = 0; unsigned kmin = 0xFFFFFFFFu;
#pragma unroll
    for (int j = 0; j < NJ; ++j) {
        const bool keep = uk[j] >= T && uk[j] != 0u;
        const unsigned long long km = __ballot(keep);
        const int np = wbase + mbcnt64(km); wbase += __builtin_popcountll(km);
        if (keep) { buf[np] = uk[j]; kmin = uk[j] < kmin ? uk[j] : kmin; }
    }
    return wave_min_u(kmin);
}
__device__ __forceinline__ unsigned select_exact(LAS unsigned* buf, const int n, const int K, const int lane) {
    if (n <= 384) return select_exact_n<6>(buf, n, K, lane);
    if (n <= 640) return select_exact_n<10>(buf, n, K, lane);
    return select_exact_n<CAP / 64>(buf, n, K, lane);
}

__device__ __forceinline__ unsigned prune_fast(LAS unsigned* buf, const int n, const int lane, int& ncnt) {
    constexpr int NJ = CAP / 64;
    unsigned uk[NJ];
#pragma unroll
    for (int j = 0; j < NJ; ++j) { const int p = j * 64 + lane; const unsigned w = buf[p]; uk[j] = p < n ? w : 0u; }
    const unsigned v = buf[(lane * n) >> 6];
    const unsigned smin = wave_min_u(v), smax = wave_max_u(v);
    int rs = (64 * (TOPK + 128)) / n; rs = rs < 4 ? 4 : (rs > 60 ? 60 : rs);
    unsigned T = smax;
    if (smin != smax) {
        const int hb = 31 - __builtin_clz(smin ^ smax);
        T = (hb == 31) ? 0u : (smax & ~((2u << hb) - 1u));
        int it = 0;
        for (int bit = hb; bit >= 0 && it < 18; --bit, ++it) {
            const unsigned cand = T | (1u << bit);
            if (__builtin_popcountll(__ballot(v >= cand)) >= rs) T = cand;
        }
    }
    int call = 0;
#pragma unroll
    for (int j = 0; j < NJ; ++j) call += __builtin_popcountll(__ballot(uk[j] >= T && uk[j] != 0u));
    if (call < TOPK || call > TOPK + 288) { ncnt = TOPK; return select_exact(buf, n, TOPK, lane); }
    int wbase = 0;
#pragma unroll
    for (int j = 0; j < NJ; ++j) {
        const bool keep = uk[j] >= T && uk[j] != 0u;
        const unsigned long long km = __ballot(keep);
        const int np = wbase + mbcnt64(km); wbase += __builtin_popcountll(km);
        if (keep) buf[np] = uk[j];
    }
    ncnt = call;
    return T;
}

__device__ __forceinline__ f16x4 tr_read(unsigned lds_addr) { f16x4 r; asm volatile("ds_read_b64_tr_b16 %0, %1\n\ts_waitcnt lgkmcnt(0)" : "=&v"(r) : "v"(lds_addr) : "memory"); return r; }

template <int WIN>
__device__ __forceinline__ void p3_pool_body(const f16* U, f16* AO, const int t0, const int s0, const int c8) {
    f16x8 R[WIN - 1 + 16];
#pragma unroll
    for (int k = 0; k < WIN - 1 + 16; ++k) {
        R[k] = (f16x8){0, 0, 0, 0, 0, 0, 0, 0};
        if (s0 - (WIN - 1) + k >= 0) R[k] = *(const f16x8*)(U + (size_t)(t0 - (WIN - 1) + k) * 512 + c8);
    }
    float S[8];
#pragma unroll
    for (int e = 0; e < 8; ++e) S[e] = 0.f;
#pragma unroll
    for (int k = 0; k < WIN - 1; ++k)
#pragma unroll
        for (int e = 0; e < 8; ++e) S[e] += (float)R[k][e];
#pragma unroll
    for (int i = 0; i < 16; ++i) {
        const int sp = s0 + i;
        const int nw = (sp + 1) < WIN ? (sp + 1) : WIN;
        const float inv = 1.f / (float)nw; f16x8 o;
#pragma unroll
        for (int e = 0; e < 8; ++e) { S[e] += (float)R[WIN - 1 + i][e]; o[e] = (f16)(S[e] * inv - (float)R[WIN - 1 + i][e]); }
        *(f16x8*)(AO + (size_t)(t0 + i) * DM + 512 + c8) = o;
#pragma unroll
        for (int e = 0; e < 8; ++e) S[e] -= (float)R[i][e];
    }
}
__device__ __forceinline__ void p3_pool(const Frame& F, const int chunk) {
    const f16* U = FPTR(f16, WS_U); f16* AO = FPTR(f16, WS_AO);
    const int g = F.wave & 3, tblk = chunk * 8 + (F.wave >> 2) * 4 + (F.lane >> 4), c8 = g * 128 + (F.lane & 15) * 8;
    const int t0 = tblk * 16, s0 = t0 & (SEQ - 1);
    if (g == 0) p3_pool_body<2>(U, AO, t0, s0, c8);
    else if (g == 1) p3_pool_body<4>(U, AO, t0, s0, c8);
    else if (g == 2) p3_pool_body<8>(U, AO, t0, s0, c8);
    else p3_pool_body<16>(U, AO, t0, s0, c8);
}

#define P3_BAR() do { asm volatile("s_waitcnt lgkmcnt(0)" ::: "memory"); __builtin_amdgcn_s_barrier(); asm volatile("" ::: "memory"); } while (0)
__device__ __forceinline__ void tr_read8(unsigned ad, f16x4 (&v)[8]) {
    asm volatile("ds_read_b64_tr_b16 %0, %8\n\tds_read_b64_tr_b16 %1, %8 offset:3840\n\t"
                 "ds_read_b64_tr_b16 %2, %8 offset:32\n\tds_read_b64_tr_b16 %3, %8 offset:3872\n\t"
                 "ds_read_b64_tr_b16 %4, %8 offset:64\n\tds_read_b64_tr_b16 %5, %8 offset:3904\n\t"
                 "ds_read_b64_tr_b16 %6, %8 offset:96\n\tds_read_b64_tr_b16 %7, %8 offset:3936\n\t"
                 "s_waitcnt lgkmcnt(0)"
                 : "=&v"(v[0]), "=&v"(v[1]), "=&v"(v[2]), "=&v"(v[3]), "=&v"(v[4]), "=&v"(v[5]), "=&v"(v[6]), "=&v"(v[7]) : "v"(ad) : "memory");
}

__device__ __forceinline__ void p3_dsa(const Frame& F) {
    const int lane = F.lane, wid = F.wave, half = lane >> 5, c31 = lane & 31;
    LAS unsigned char* wl = F.lds + P3_RING + wid * P3_WAVE_LDS;
    LAS unsigned* cb = (LAS unsigned*)wl;
    volatile LAS unsigned* flg = (volatile LAS unsigned*)(F.lds + LDS_MISC + 64);
    const int nwgb = F.G >> 2;
    const int b0 = blockIdx.x & 3, wgb = blockIdx.x >> 2;
    const int qq = 2 * ((c31 >> 2) & 1) + (c31 >> 4), hd = (c31 & 3) + 4 * ((c31 >> 3) & 1);
    const int drow = 8 * wid + (lane >> 3), dpart = (lane & 7) ^ ((drow >> 1) & 7);
    unsigned boff[4];
#pragma unroll
    for (int ks = 0; ks < 4; ++ks) boff[ks] = (unsigned)(c31 * 128 + (((2 * ks + half) ^ ((c31 >> 1) & 7)) << 4));
    constexpr int WMARK = CAP - 128;
    unsigned* uctr = FPTR(unsigned, WS_CTL) + CW_P3Q;
    int ucode = (b0 << 16) | wgb;
    while (ucode >= 0) {
        const int b = ucode >> 16, posr = ucode & 0xFFFF;
        const size_t tb = (size_t)b * SEQ;
        const f16* dsrc = FPTR(f16, WS_KI) + (tb + drow) * 64 + dpart * 8;
        const int T0 = (SEQ / 32 - 1 - posr) * 32;
        const int t0 = T0 + 4 * wid;
        const int nstage = (T0 + 31) / 128 + 1;
        P3_BAR();
        if (F.tid < 3) flg[F.tid] = 0u;
        if (F.tid == 0) {
            int code = -1;
            for (int k = 0; k < 4 && code < 0; ++k) { const int bb = (b0 + k) & 3; const unsigned n = atomicAdd(uctr + 64 * bb, 1u) + (unsigned)nwgb; if (n < (unsigned)(SEQ / 32)) code = (bb << 16) | (int)n; }
            flg[4] = (unsigned)code;
        }
        __builtin_amdgcn_global_load_lds((const unsigned*)(dsrc), (LAS unsigned*)(F.lds + wid * 1024), 16, 0, 0);
        __builtin_amdgcn_global_load_lds((const unsigned*)(dsrc + (size_t)64 * 64), (LAS unsigned*)(F.lds + 8192 + wid * 1024), 16, 0, 0);
        f16x8 Af[4];
        { const f16* qip = FPTR(f16, WS_QI) + (tb + t0 + qq) * 512 + hd * 64 + 8 * half;
#pragma unroll
          for (int s4 = 0; s4 < 4; ++s4) Af[s4] = *(const f16x8*)(qip + 16 * s4); }
        float wv0[8], wv1[8];
        { const float* wp = FPTR(float, WS_WI) + (tb + t0 + 2 * half) * 8;
          const f32x4 a0 = *(const f32x4*)wp, a1 = *(const f32x4*)(wp + 4), b0 = *(const f32x4*)(wp + 8), b1 = *(const f32x4*)(wp + 12);
#pragma unroll
          for (int e = 0; e < 4; ++e) { wv0[e] = a0[e]; wv0[4 + e] = a1[e]; wv1[e] = b0[e]; wv1[4 + e] = b1[e]; } }
        asm volatile("s_waitcnt vmcnt(0)" :: "v"(Af[0]), "v"(Af[1]), "v"(Af[2]), "v"(Af[3]),
                     "v"(wv0[0]), "v"(wv0[1]), "v"(wv0[2]), "v"(wv0[3]), "v"(wv0[4]), "v"(wv0[5]), "v"(wv0[6]), "v"(wv0[7]),
                     "v"(wv1[0]), "v"(wv1[1]), "v"(wv1[2]), "v"(wv1[3]), "v"(wv1[4]), "v"(wv1[5]), "v"(wv1[6]), "v"(wv1[7]) : "memory");
        float tau0 = -__builtin_inff(), tau1 = -__builtin_inff();
        int cnt0 = 0, cnt1 = 0, cnt2 = 0, cnt3 = 0;
        const int tq0 = t0 + 2 * half, tq1 = tq0 + 1;
        for (int st = 0; st < nstage; ++st) {
            if (st > 0) asm volatile("s_waitcnt vmcnt(0)" ::: "memory");
            P3_BAR();
            {
                const int sn = (st + 1 < nstage) ? st + 1 : nstage - 1;
                __builtin_amdgcn_global_load_lds((const unsigned*)(dsrc + (size_t)sn * 128 * 64), (LAS unsigned*)(F.lds + ((st + 1) & 1) * 16384 + wid * 1024), 16, 0, 0);
                __builtin_amdgcn_global_load_lds((const unsigned*)(dsrc + (size_t)(sn * 128 + 64) * 64), (LAS unsigned*)(F.lds + ((st + 1) & 1) * 16384 + 8192 + wid * 1024), 16, 0, 0);
            }
            unsigned fl = 0u;
            if (st >= 1) fl = flg[(st - 1) % 3];
            if (st >= 2 && F.tid == 0) flg[(st - 2) % 3] = 0u;
            fl = (unsigned)__builtin_amdgcn_readfirstlane((int)fl);
            if (fl) {
                if (cnt0 > TOPK + 160) { int nc; const float tv = pack_floor(prune_fast(cb + 0 * CAP, cnt0, lane, nc)); cnt0 = nc; if (!half) tau0 = tv; }
                if (cnt1 > TOPK + 160) { int nc; const float tv = pack_floor(prune_fast(cb + 1 * CAP, cnt1, lane, nc)); cnt1 = nc; if (!half) tau1 = tv; }
                if (cnt2 > TOPK + 160) { int nc; const float tv = pack_floor(prune_fast(cb + 2 * CAP, cnt2, lane, nc)); cnt2 = nc; if (half) tau0 = tv; }
                if (cnt3 > TOPK + 160) { int nc; const float tv = pack_floor(prune_fast(cb + 3 * CAP, cnt3, lane, nc)); cnt3 = nc; if (half) tau1 = tv; }
            }
            LAS unsigned char* slot = F.lds + (st & 1) * 16384;
            const int kst0 = st * 128;
            if (kst0 <= t0 + 3) {
                f32x16 acc[4];
#pragma unroll
                for (int j = 0; j < 4; ++j) acc[j] = (f32x16){0.f, 0.f, 0.f, 0.f, 0.f, 0.f, 0.f, 0.f, 0.f, 0.f, 0.f, 0.f, 0.f, 0.f, 0.f, 0.f};
                {
                    f16x8 Bf[4][4];
#pragma unroll
                    for (int j = 0; j < 4; ++j)
#pragma unroll
                        for (int ks = 0; ks < 4; ++ks) Bf[j][ks] = *(const LAS f16x8*)(slot + j * 4096 + boff[ks]);
#pragma unroll
                    for (int ks = 0; ks < 4; ++ks)
#pragma unroll
                        for (int j = 0; j < 4; ++j) acc[j] = __builtin_amdgcn_mfma_f32_32x32x16_f16(Af[ks], Bf[j][ks], acc[j], 0, 0, 0);
                }
#pragma unroll
                for (int j = 0; j < 4; ++j) {
                    float a0 = 0.f, a1 = 0.f, b0 = 0.f, b1 = 0.f;
#pragma unroll
                    for (int h = 0; h < 8; h += 2) {
                        a0 = fmaf(wv0[h], __int_as_float(max(__float_as_int(acc[j][h]), 0)), a0);
                        a1 = fmaf(wv0[h + 1], __int_as_float(max(__float_as_int(acc[j][h + 1]), 0)), a1);
                        b0 = fmaf(wv1[h], __int_as_float(max(__float_as_int(acc[j][8 + h]), 0)), b0);
                        b1 = fmaf(wv1[h + 1], __int_as_float(max(__float_as_int(acc[j][8 + h + 1]), 0)), b1);
                    }
                    const float s0 = a0 + a1, s1 = b0 + b1;
                    const int key = kst0 + j * 32 + c31;
                    const bool h0 = (key <= tq0) && (s0 >= tau0), h1 = (key <= tq1) && (s1 >= tau1);
                    const unsigned long long m0 = __ballot(h0), m1 = __ballot(h1);
                    if (m0) {
                        const unsigned lo = (unsigned)m0, hi = (unsigned)(m0 >> 32);
                        const int pre = mbcnt64(m0) - (half ? __builtin_popcount(lo) : 0);
                        const int p = (half ? cnt2 : cnt0) + pre;
                        if (h0) cb[(2 * half) * CAP + p] = pack_cand(s0, key);
                        cnt0 += __builtin_popcount(lo); cnt2 += __builtin_popcount(hi);
                    }
                    if (m1) {
                        const unsigned lo = (unsigned)m1, hi = (unsigned)(m1 >> 32);
                        const int pre = mbcnt64(m1) - (half ? __builtin_popcount(lo) : 0);
                        const int p = (half ? cnt3 : cnt1) + pre;
                        if (h1) cb[(2 * half + 1) * CAP + p] = pack_cand(s1, key);
                        cnt1 += __builtin_popcount(lo); cnt3 += __builtin_popcount(hi);
                    }
                }
            }
            if (max(max(cnt0, cnt1), max(cnt2, cnt3)) > WMARK && lane == 0) flg[st % 3] = 1u;
        }
        asm volatile("s_waitcnt vmcnt(0)" ::: "memory");
        if (cnt0 > TOPK) { (void)select_exact(cb + 0 * CAP, cnt0, TOPK, lane); cnt0 = TOPK; }
        if (cnt1 > TOPK) { (void)select_exact(cb + 1 * CAP, cnt1, TOPK, lane); cnt1 = TOPK; }
        if (cnt2 > TOPK) { (void)select_exact(cb + 2 * CAP, cnt2, TOPK, lane); cnt2 = TOPK; }
        if (cnt3 > TOPK) { (void)select_exact(cb + 3 * CAP, cnt3, TOPK, lane); cnt3 = TOPK; }
        {
        const int hcol = lane & 15, g4 = lane >> 4;
        const unsigned vst = (unsigned)(size_t)wl + 1024u;
        const unsigned trb = vst + (unsigned)((4 * g4 + (hcol >> 2)) * 128 + 4 * (hcol & 3) * 2);
        const f16* KVb = FPTR(f16, WS_KV) + tb * 128;
        const f16* Qb = FPTR(f16, WS_Q) + (tb + t0) * 512 + hcol * 64 + 8 * g4;
        f16x8 vv[8], ka[4][2], Bq[2], Bqn[2];
#define P3_NSEL(q_) ((q_) == 0 ? cnt0 : (q_) == 1 ? cnt1 : (q_) == 2 ? cnt2 : cnt3)
#define P3_GATHER(q_, c_) do { const int ns_ = P3_NSEL(q_); LAS unsigned* iq_ = cb + (q_) * CAP; \
            unsigned wv_[12];     \
            _Pragma("unroll") for (int jj = 0; jj < 8; ++jj) wv_[jj] = iq_[(c_) * 64 + ((lane + 64 * jj) >> 3)]; \
            _Pragma("unroll") for (int k4 = 0; k4 < 4; ++k4) wv_[8 + k4] = iq_[(4 * (c_) + k4) * 16 + hcol]; \
            _Pragma("unroll") for (int jj = 0; jj < 8; ++jj) { const int p_ = lane + 64 * jj, slot_ = (c_) * 64 + (p_ >> 3); const int idx_ = slot_ < ns_ ? 8191 - (int)(wv_[jj] & 0x1FFFu) : 0; \
                vv[jj] = *(const f16x8*)(KVb + (size_t)idx_ * 128 + 64 + (p_ & 7) * 8); } \
            _Pragma("unroll") for (int k4 = 0; k4 < 4; ++k4) { const int slot_ = (4 * (c_) + k4) * 16 + hcol; const int idx_ = slot_ < ns_ ? 8191 - (int)(wv_[8 + k4] & 0x1FFFu) : 0; \
                const f16* kp_ = KVb + (size_t)idx_ * 128 + 8 * g4; ka[k4][0] = *(const f16x8*)kp_; ka[k4][1] = *(const f16x8*)(kp_ + 32); } } while (0)
#define P3_LOADQ(dst_, q_) do { _Pragma("unroll") for (int ks = 0; ks < 2; ++ks) { dst_[ks] = (f16x8){0, 0, 0, 0, 0, 0, 0, 0}; if (hcol < 8) dst_[ks] = *(const f16x8*)(Qb + (q_) * 512 + 32 * ks); } } while (0)
        int q = 0, c = 0;
        P3_GATHER(0, 0); P3_LOADQ(Bq, 0);
        f32x4 O[4];
#pragma unroll
        for (int mt = 0; mt < 4; ++mt) O[mt] = (f32x4){0.f, 0.f, 0.f, 0.f};
        float mrun = -__builtin_inff(), lrun = 0.f;
#pragma unroll 1
        for (;;) {
            const int nsel = P3_NSEL(q);
#pragma unroll
            for (int jj = 0; jj < 8; ++jj) { const int p = lane + 64 * jj, kk = p >> 3; *(LAS f16x8*)(wl + (kk >> 4) * P3_QB + 1024 + (kk & 15) * 128 + (p & 7) * 16) = vv[jj]; }
            float lg[4][4];
#pragma unroll
            for (int k4 = 0; k4 < 4; ++k4) {
                f32x4 d = {0.f, 0.f, 0.f, 0.f};
                d = __builtin_amdgcn_mfma_f32_16x16x32_f16(ka[k4][0], Bq[0], d, 0, 0, 0);
                d = __builtin_amdgcn_mfma_f32_16x16x32_f16(ka[k4][1], Bq[1], d, 0, 0, 0);
#pragma unroll
                for (int r = 0; r < 4; ++r) lg[k4][r] = ((4 * c + k4) * 16 + 4 * g4 + r < nsel) ? d[r] : -__builtin_inff();
            }
            const bool lastc = (c + 1) * 64 >= nsel;
            const int qn = lastc ? q + 1 : q, cn = lastc ? 0 : c + 1;
            const bool has_next = qn < 4;
            if (has_next) { P3_GATHER(qn, cn); if (lastc) P3_LOADQ(Bqn, qn); }
            float cm = -__builtin_inff();
#pragma unroll
            for (int k4 = 0; k4 < 4; ++k4)
#pragma unroll
                for (int r = 0; r < 4; ++r) cm = fmaxf(cm, lg[k4][r]);
            { const auto pr = __builtin_amdgcn_permlane32_swap(__float_as_uint(cm), __float_as_uint(cm), false, false); cm = fmaxf(__uint_as_float(pr[0]), __uint_as_float(pr[1])); }
            cm = fmaxf(cm, __shfl_xor(cm, 16));
            const float mnew = fmaxf(mrun, cm);
            const float alpha = __expf(mrun - mnew);
            mrun = mnew; lrun *= alpha;
#pragma unroll
            for (int mt = 0; mt < 4; ++mt) O[mt] *= alpha;
#pragma unroll
            for (int k4 = 0; k4 < 4; ++k4)
#pragma unroll
                for (int r = 0; r < 4; ++r) { const float e = __expf(lg[k4][r] - mnew); lg[k4][r] = e; lrun += e; }
#pragma unroll
            for (int k2 = 0; k2 < 2; ++k2) {
                f16x8 Bp;
#pragma unroll
                for (int r = 0; r < 4; ++r) { Bp[r] = (f16)lg[2 * k2][r]; Bp[4 + r] = (f16)lg[2 * k2 + 1][r]; }
                f16x4 tv[8];
                tr_read8(trb + (unsigned)(k2 * 2 * P3_QB), tv);
#pragma unroll
                for (int mt = 0; mt < 4; ++mt) {
                    const f16x4 v0 = tv[2 * mt], v1 = tv[2 * mt + 1];
                    const f16x8 Av = {v0[0], v0[1], v0[2], v0[3], v1[0], v1[1], v1[2], v1[3]};
                    O[mt] = __builtin_amdgcn_mfma_f32_16x16x32_f16(Av, Bp, O[mt], 0, 0, 0);
                }
            }
            if (lastc) {
                { const auto pr = __builtin_amdgcn_permlane32_swap(__float_as_uint(lrun), __float_as_uint(lrun), false, false); lrun = __uint_as_float(pr[0]) + __uint_as_float(pr[1]); }
                lrun += __shfl_xor(lrun, 16);
                const float inv = 1.f / lrun;
                if (hcol < 8) {
#pragma unroll
                    for (int mt = 0; mt < 4; ++mt) { f16x4 o;
_Pragma("unroll") for (int r = 0; r < 4; ++r) o[r] = (f16)(O[mt][r] * inv);
                        *(f16x4*)(FPTR(f16, WS_AO) + (tb + t0 + q) * DM + hcol * 64 + 16 * mt + 4 * g4) = o; }
                }
#pragma unroll
                for (int mt = 0; mt < 4; ++mt) O[mt] = (f32x4){0.f, 0.f, 0.f, 0.f};
                mrun = -__builtin_inff(); lrun = 0.f;
                Bq[0] = Bqn[0]; Bq[1] = Bqn[1];
            }
            if (!has_next) break;
            q = qn; c = cn;
        }
#undef P3_NSEL
#undef P3_GATHER
#undef P3_LOADQ
        }
        ucode = __builtin_amdgcn_readfirstlane((int)flg[4]);
    }
}

struct EpiOut {
    const float* x; f16* x1h; const float* MOD;
    __device__ __forceinline__ void operator()(const f32x4 (&acc)[2][2][4][2], const gm::DenseSched::Unit& u, int wr, int wc, int fr, int fq) const {
        asm volatile("" : "+v"(fr), "+v"(fq));
        const int b = (u.pm * 256) / SEQ;
        f32x4 gt[2][2];
#pragma unroll
        for (int bj = 0; bj < 2; ++bj)
#pragma unroll
            for (int n = 0; n < 2; ++n) gt[bj][n] = *(const f32x4*)(MOD + (size_t)b * 6144 + 2048 + u.pn * 256 + bj * 128 + wc * 32 + fq * 8 + n * 4);
#pragma unroll
        for (int ai = 0; ai < 2; ++ai) {
            f32x4 xv[4][2][2];
#pragma unroll
            for (int m = 0; m < 4; ++m) {
                const size_t t = (size_t)u.pm * 256 + ai * 128 + wr * 64 + m * 16 + fr;
#pragma unroll
                for (int bj = 0; bj < 2; ++bj) { const size_t o = t * DM + u.pn * 256 + bj * 128 + wc * 32 + fq * 8; xv[m][bj][0] = *(const f32x4*)(x + o); xv[m][bj][1] = *(const f32x4*)(x + o + 4); }
            }
#pragma unroll
            for (int m = 0; m < 4; ++m) {
                const size_t t = (size_t)u.pm * 256 + ai * 128 + wr * 64 + m * 16 + fr;
#pragma unroll
                for (int bj = 0; bj < 2; ++bj) { const size_t o = t * DM + u.pn * 256 + bj * 128 + wc * 32 + fq * 8;
                    const f32x4 r0 = xv[m][bj][0] + gt[bj][0] * acc[ai][bj][m][0], r1 = xv[m][bj][1] + gt[bj][1] * acc[ai][bj][m][1]; f16x8 h;
_Pragma("unroll") for (int e = 0; e < 4; ++e) { h[e] = (f16)r0[e]; h[4 + e] = (f16)r1[e]; }
                    *(f16x8*)(x1h + o) = h; }
            }
        }
    }
};

__device__ __forceinline__ void p5_norm_route(const Frame& F, const Args& a) {
    LAS float* gs = (LAS float*)F.lds; LAS float* sh = gs + 1024;
    LAS float* cvec = sh + 1024;
    LAS float* lgl = cvec + 64;
    LAS int* sel_e = (LAS int*)(lgl + 8 * 16 * 40);
    LAS float* sel_c = (LAS float*)(sel_e + 256);
    LAS int* sel_p = (LAS int*)(sel_c + 256);
    LAS int* cntL = sel_p + 256;
    LAS int* baseL = cntL + 32;
    const f16* x1 = FPTR(f16, WS_X1H);
    const float* WRT = FPTR(float, WS_WRT);
    const int lane = F.lane, r16 = lane & 15, g4 = lane >> 4;
    int curb = -1;
    for (int rb = blockIdx.x; rb < NT / 128; rb += F.G) {
        const int b = (rb * 128) / SEQ;
        __syncthreads();
        if (b != curb) {
            for (int cidx = F.tid; cidx < 1024; cidx += 512) { sh[cidx] = FPTR(float, WS_MOD)[(size_t)b * 6144 + 3072 + cidx]; gs[cidx] = a.g_ffn[cidx] * (1.f + FPTR(float, WS_MOD)[(size_t)b * 6144 + 4096 + cidx]); }
            __syncthreads();
            for (int o = F.wave; o < 36; o += 8) {
                float sacc = 0.f;
#pragma unroll
                for (int j = 0; j < 4; ++j) { const f32x4 w = *(const f32x4*)(WRT + (size_t)o * 1024 + 256 * j + 4 * lane);
#pragma unroll
                    for (int e = 0; e < 4; ++e) sacc += sh[256 * j + 4 * lane + e] * w[e]; }
                sacc = wave_sum(sacc);
                if (lane == 0) cvec[o] = sacc + (o < 4 ? a.b_rg[o] : a.b_re[o - 4]);
            }
            curb = b;
        }
        if (F.tid < 32) cntL[F.tid] = 0;
        __syncthreads();
        const size_t row0 = (size_t)rb * 128 + F.wave * 16;
        const f16* xp = x1 + (row0 + r16) * DM + 8 * g4;
        f32x4 accA[3], accB[3];
#pragma unroll
        for (int nt = 0; nt < 3; ++nt) { accA[nt] = (f32x4){0.f, 0.f, 0.f, 0.f}; accB[nt] = accA[nt]; }
        float ss = 0.f;
        LAS f16* Wsh = (LAS f16*)(F.lds + 32768); LAS f16* Wsl = Wsh + 48 * 520;
#pragma unroll 1
        for (int kh = 0; kh < 2; ++kh) {
            __syncthreads();
            for (int c = F.tid; c < 48 * 64; c += 512) {
                const int o = c >> 6, k8 = (c & 63) * 8;
                *(LAS f16x8*)(Wsh + o * 520 + k8) = *(const f16x8*)(FPTR(f16, WS_WRH) + (size_t)o * 1024 + kh * 512 + k8);
                *(LAS f16x8*)(Wsl + o * 520 + k8) = *(const f16x8*)(FPTR(f16, WS_WRL) + (size_t)o * 1024 + kh * 512 + k8);
            }
            __syncthreads();
#pragma unroll 2
            for (int k2 = 0; k2 < 16; ++k2) {
                const int ks = kh * 16 + k2;
                const f16x8 xh = *(const f16x8*)(xp + 32 * ks);
                const f32x4 g0 = *(const LAS f32x4*)(gs + 32 * ks + 8 * g4), g1 = *(const LAS f32x4*)(gs + 32 * ks + 8 * g4 + 4);
                f16x8 bh[3], bl[3];
#pragma unroll
                for (int nt = 0; nt < 3; ++nt) { bh[nt] = *(const LAS f16x8*)(Wsh + (nt * 16 + r16) * 520 + 32 * k2 + 8 * g4); bl[nt] = *(const LAS f16x8*)(Wsl + (nt * 16 + r16) * 520 + 32 * k2 + 8 * g4); }
                f16x8 ahi, alo;
#pragma unroll
                for (int j = 0; j < 8; ++j) {
                    const float xv = (float)xh[j]; ss += xv * xv;
                    const float av = xv * (j < 4 ? g0[j] : g1[j - 4]);
                    ahi[j] = (f16)av; alo[j] = (f16)((av - (float)ahi[j]) * 2048.f);
                }
#pragma unroll
                for (int nt = 0; nt < 3; ++nt) {
                    accA[nt] = __builtin_amdgcn_mfma_f32_16x16x32_f16(ahi, bh[nt], accA[nt], 0, 0, 0);
                    accB[nt] = __builtin_amdgcn_mfma_f32_16x16x32_f16(alo, bh[nt], accB[nt], 0, 0, 0);
                    accB[nt] = __builtin_amdgcn_mfma_f32_16x16x32_f16(ahi, bl[nt], accB[nt], 0, 0, 0);
                }
            }
        }
        f32x4 acc[3];
#pragma unroll
        for (int nt = 0; nt < 3; ++nt) acc[nt] = accA[nt] + accB[nt] * (1.f / 2048.f);
        ss += __shfl_xor(ss, 16); ss += __shfl_xor(ss, 32);
        const float rstd = rsqrtf(ss * (1.f / 1024.f) + EPSN);
#pragma unroll
        for (int e = 0; e < 4; ++e) {
            const float rs = __shfl(rstd, 4 * g4 + e);
#pragma unroll
            for (int nt = 0; nt < 3; ++nt) { const int o = nt * 16 + r16; if (o < 36) lgl[(F.wave * 16 + 4 * g4 + e) * 40 + o] = rs * acc[nt][e] + cvec[o]; }
        }
        if (lane < 16) {
            float L[36];
#pragma unroll
            for (int o = 0; o < 36; ++o) L[o] = lgl[(F.wave * 16 + lane) * 40 + o];
            int gsel = 0; float gmax = -__builtin_inff();
#pragma unroll
            for (int g = 0; g < 4; ++g) if (L[g] > gmax) { gmax = L[g]; gsel = g; }
            float gden = 0.f;
#pragma unroll
            for (int g = 0; g < 4; ++g) gden += __expf(L[g] - gmax);
            const float pg = 1.f / gden;
            float el[8];
#pragma unroll
            for (int e = 0; e < 8; ++e) {
                float v = 0.f;
#pragma unroll
                for (int g = 0; g < 4; ++g) v = (gsel == g) ? L[4 + g * 8 + e] : v;
                el[e] = v;
            }
            int e1 = 0; float m1 = -__builtin_inff();
#pragma unroll
            for (int e = 0; e < 8; ++e) if (el[e] > m1) { m1 = el[e]; e1 = e; }
            int e2 = 0; float m2 = -__builtin_inff();
#pragma unroll
            for (int e = 0; e < 8; ++e) if (e != e1 && el[e] > m2) { m2 = el[e]; e2 = e; }
            const float p2 = __expf(m2 - m1), den = 1.f + p2;
            const int tl = F.wave * 16 + lane;
            sel_e[tl * 2] = gsel * 8 + e1; sel_e[tl * 2 + 1] = gsel * 8 + e2;
            sel_c[tl * 2] = pg / den; sel_c[tl * 2 + 1] = pg * p2 / den;
        }
#pragma unroll 1
        for (int rq = 0; rq < 4; ++rq) {
            f32x4 v[4][4];
#pragma unroll
            for (int r = 0; r < 4; ++r)
#pragma unroll
                for (int j = 0; j < 4; ++j) { const f16x4 xh = *(const f16x4*)(x1 + (row0 + rq * 4 + r) * DM + 256 * j + 4 * lane); v[r][j] = (f32x4){(float)xh[0], (float)xh[1], (float)xh[2], (float)xh[3]}; }
#pragma unroll
            for (int r = 0; r < 4; ++r) {
                const float rs = __int_as_float(__builtin_amdgcn_readlane(__float_as_int(rstd), rq * 4 + r));
                const size_t t = row0 + rq * 4 + r;
#pragma unroll
                for (int j = 0; j < 4; ++j) {
                    const int c0 = 256 * j + 4 * lane; f16x4 o;
#pragma unroll
                    for (int e = 0; e < 4; ++e) o[e] = (f16)(v[r][j][e] * rs * gs[c0 + e] + sh[c0 + e]);
                    *(f16x4*)(FPTR(f16, WS_H) + t * DM + c0) = o;
                }
            }
        }
        __syncthreads();
        if (F.tid < 256) sel_p[F.tid] = __hip_atomic_fetch_add(&cntL[sel_e[F.tid]], 1, __ATOMIC_RELAXED, __HIP_MEMORY_SCOPE_WORKGROUP);
        __syncthreads();
        if (F.tid < 32) baseL[F.tid] = (int)atomicAdd(FPTR(unsigned, WS_CTL) + CW_CNT + F.tid, (unsigned)cntL[F.tid]);
        __syncthreads();
        if (F.tid < 256) {
            const int e = sel_e[F.tid], p = baseL[e] + sel_p[F.tid];
            const int t = rb * 128 + (F.tid >> 1);
            FPTR(int, WS_LISTT)[(size_t)e * NT + p] = t; FPTR(float, WS_LISTC)[(size_t)e * NT + p] = sel_c[F.tid];
            FPTR(unsigned, WS_TOKROW)[(size_t)t * 2 + (F.tid & 1)] = ((unsigned)e << 20) | (unsigned)p;
        }
    }
}

struct MoeTables { LAS int* pre; LAS int* cnt; LAS unsigned char* tmap; };
__device__ __forceinline__ void moe_tables_build(const Frame& F, MoeTables& mt) {
    mt.pre = (LAS int*)(F.lds + LDS_MISC + 256); mt.cnt = mt.pre + 40; mt.tmap = (LAS unsigned char*)(mt.pre + 80);
    __syncthreads();
    if (F.tid < 32) mt.cnt[F.tid] = (int)__hip_atomic_load(FPTR(unsigned, WS_CTL) + CW_CNT + F.tid, __ATOMIC_RELAXED, __HIP_MEMORY_SCOPE_AGENT);
    __syncthreads();
    if (F.tid == 0) {
        int acc = 0;
        for (int e = 0; e < NEXP; ++e) { mt.pre[e] = acc; acc += (mt.cnt[e] + 255) >> 8; }
        mt.pre[NEXP] = acc;
    }
    __syncthreads();
    for (int tl = F.tid; tl < mt.pre[NEXP]; tl += 512) {
        int e = 0;
        for (int k = 1; k < NEXP; ++k) e = (tl >= mt.pre[k]) ? k : e;
        mt.tmap[tl] = (unsigned char)e;
    }
    __syncthreads();
}
template <int NPN, int KDIM, bool GATHER_>
struct MoeSched {
    static constexpr bool GATHER = GATHER_;
    struct Unit { int e, mt, pn, cnt; };
    MoeTables T; int G, c; const int* listt; const char* Bt; size_t bexp;
    __device__ __forceinline__ bool next(int i, Unit& u) const {
        const int L0 = i * G + c, total = T.pre[NEXP], nwg = total * NPN;
        if (L0 >= nwg) return false;
        int L; { const int q = nwg / 8, r = nwg % 8, xcd = L0 % 8, off = L0 / 8; L = (xcd < r ? xcd * (q + 1) : r * (q + 1) + (xcd - r) * q) + off; }
        const int tl = L / NPN; u.pn = L - tl * NPN;
        u.e = __builtin_amdgcn_readfirstlane((int)T.tmap[tl]); u.mt = tl - T.pre[u.e]; u.cnt = T.cnt[u.e]; u.cnt = __builtin_amdgcn_readfirstlane(u.cnt); u.mt = __builtin_amdgcn_readfirstlane(u.mt);
        return true;
    }
    __device__ __forceinline__ unsigned arow(const Unit& u, int r) const {
        const int li = u.mt * 256 + r;
        if (GATHER) return (unsigned)listt[(size_t)u.e * NT + (li < u.cnt ? li : 0)];
        return (unsigned)(T.pre[u.e] * 256 + li);
    }
    __device__ __forceinline__ const int* arowp(const Unit& u, int r) const { const int li = u.mt * 256 + r; return listt + (size_t)u.e * NT + (li < u.cnt ? li : 0); }
    __device__ __forceinline__ size_t abase(const Unit& u) const { return (size_t)(T.pre[u.e] * 256 + u.mt * 256) * KDIM * 2; }
    __device__ __forceinline__ const char* bptr(const Unit& u) const { return Bt + (size_t)u.e * bexp + (size_t)u.pn * 256 * KDIM * 2; }
};
typedef MoeSched<2, 1024, true> MoeSched1;
typedef MoeSched<4, 256, false> MoeSched2;

struct EpiSwiglu {
    f16* ACT; MoeTables T;
    __device__ __forceinline__ void operator()(const f32x4 (&acc)[2][2][4][2], const MoeSched1::Unit& u, int wr, int wc, int fr, int fq) const {
        const size_t rbase = (size_t)T.pre[u.e] * 256 + (size_t)u.mt * 256;
#pragma unroll
        for (int ai = 0; ai < 2; ++ai)
#pragma unroll
            for (int m = 0; m < 4; ++m) {
                const size_t row = rbase + ai * 128 + wr * 64 + m * 16 + fr;
                f16x8 o;
#pragma unroll
                for (int n = 0; n < 2; ++n)
#pragma unroll
                    for (int e = 0; e < 4; ++e) o[n * 4 + e] = (f16)(silu_f(acc[ai][0][m][n][e]) * acc[ai][1][m][n][e]);
                *(f16x8*)(ACT + row * DEXP + u.pn * 128 + wc * 32 + fq * 8) = o;
            }
    }
};
struct EpiY {
    f16* Y; const float* listc; MoeTables T;
    __device__ __forceinline__ void operator()(const f32x4 (&acc)[2][2][4][2], const MoeSched2::Unit& u, int wr, int wc, int fr, int fq) const {
        const size_t rbase = (size_t)T.pre[u.e] * 256 + (size_t)u.mt * 256;
        asm volatile("" : "+v"(fr), "+v"(fq));
        float cw[2][4];
#pragma unroll
        for (int ai = 0; ai < 2; ++ai)
#pragma unroll
            for (int m = 0; m < 4; ++m) {
                const int li = u.mt * 256 + ai * 128 + wr * 64 + m * 16 + fr;
                cw[ai][m] = listc[(size_t)u.e * NT + (li < u.cnt ? li : 0)];
                cw[ai][m] = li < u.cnt ? cw[ai][m] : 0.f;
            }
#pragma unroll
        for (int ai = 0; ai < 2; ++ai)
#pragma unroll
            for (int m = 0; m < 4; ++m) {
                const size_t row = rbase + ai * 128 + wr * 64 + m * 16 + fr;
#pragma unroll
                for (int bj = 0; bj < 2; ++bj) { f16x8 o;
#pragma unroll
                    for (int n = 0; n < 2; ++n)
#pragma unroll
                        for (int e = 0; e < 4; ++e) o[n * 4 + e] = (f16)(cw[ai][m] * acc[ai][bj][m][n][e]);
                    *(f16x8*)(Y + row * DM + u.pn * 256 + bj * 128 + wc * 32 + fq * 8) = o; }
            }
    }
};

__device__ __forceinline__ void p8_combine(const Frame& F, const Args& a, const MoeTables& T) {
    for (int task = blockIdx.x * 512 + F.tid; task < NT * 128; task += F.G * 512) {
        const int t = task >> 7, c8 = (task & 127) * 8, b = t / SEQ;
        const unsigned r0 = FPTR(unsigned, WS_TOKROW)[(size_t)t * 2], r1 = FPTR(unsigned, WS_TOKROW)[(size_t)t * 2 + 1];
        const size_t row0 = (size_t)T.pre[r0 >> 20] * 256 + (r0 & 0xFFFFFu), row1 = (size_t)T.pre[r1 >> 20] * 256 + (r1 & 0xFFFFFu);
        const f16x8 y0 = *(const f16x8*)(FPTR(f16, WS_Y) + row0 * DM + c8), y1 = *(const f16x8*)(FPTR(f16, WS_Y) + row1 * DM + c8);
        const float* gp = FPTR(float, WS_MOD) + (size_t)b * 6144 + 5120 + c8;
        const f32x4 g0 = *(const f32x4*)gp, g1 = *(const f32x4*)(gp + 4);
        float* op = a.out + (size_t)t * DM + c8;
        const f16x8 xh = *(const f16x8*)(FPTR(f16, WS_X1H) + (size_t)t * DM + c8);
        f32x4 o0, o1;
#pragma unroll
        for (int e = 0; e < 4; ++e) { o0[e] = (float)xh[e] + g0[e] * ((float)y0[e] + (float)y1[e]); o1[e] = (float)xh[4 + e] + g1[e] * ((float)y0[4 + e] + (float)y1[4 + e]); }
        *(f32x4*)op = o0; *(f32x4*)(op + 4) = o1;
    }
}

__global__ void __launch_bounds__(512, 2) fwd(Args args) {
    extern __shared__ __attribute__((aligned(16))) unsigned char lds_raw[];
    Frame F;
    F.lds = (LAS unsigned char*)lds_raw;
    F.tid = threadIdx.x; F.lane = F.tid & 63; F.wave = __builtin_amdgcn_readfirstlane(F.tid >> 6); F.G = gridDim.x;
    F.ws = args.ws;
    volatile LAS unsigned* misc = (volatile LAS unsigned*)(F.lds + LDS_MISC);
    if (F.tid < 64) misc[F.tid] = 0u;
    __syncthreads();
    const int lo = args.ph_lo, hi = args.ph_hi;
    const bool fused = (hi - lo) > 1;
    XcdBarrier bar; bar.bar = (unsigned*)(FPTR(unsigned, WS_CTL) + CW_BAR); bar.x = 0; bar.st = misc;
    if (fused) bar = xcd_barrier_post((unsigned*)(FPTR(unsigned, WS_CTL) + CW_BAR), misc);
#ifndef PH_MASK
#define PH_MASK 0x1FF
#endif
#define IN(k) (((PH_MASK >> (k)) & 1) && lo <= (k) && (k) < hi)
#define SEAM(k) do { if (IN(k) && IN((k) + 1)) xcd_barrier(bar); } while (0)

    if (IN(0)) { for (int rep = 0; rep < NREP(0); ++rep) p0_prologue(F, args); } SEAM(0);
    if (IN(1)) { for (int rep = 0; rep < NREP(1); ++rep) p1_norm(F, args); } SEAM(1);
    if (IN(2)) {
        gm::DenseSched S; S.init(NT, NIN, DM, F.G, (int)blockIdx.x, FPTR(f16, WS_BTIN));
        EpiIn E{args.ws};
        for (int rep = 0; rep < NREP(2); ++rep) gm::gemm_phase<EpiIn, gm::DenseSched, true>(F.lds, (const char*)FPTR(f16, WS_H), DM, S, E);
    } SEAM(2);
    if (IN(3)) {
        p3_dsa(F);
        for (;;) {
            __syncthreads();
            if (F.tid == 0) misc[24] = atomicAdd(FPTR(unsigned, WS_CTL) + CW_P3Q + 256, 1u);
            __syncthreads();
            const int chunk = (int)misc[24];
            if (chunk >= (NT / 16) * 64 / 512) break;
            p3_pool(F, chunk);
        }
    } SEAM(3);
    if (IN(4)) {
        gm::DenseSched S; S.init(NT, DM, DM, F.G, (int)blockIdx.x, FPTR(f16, WS_BTOUT));
        EpiOut E{args.x, FPTR(f16, WS_X1H), FPTR(float, WS_MOD)};
        for (int rep = 0; rep < NREP(4); ++rep) gm::gemm_phase<EpiOut, gm::DenseSched, true>(F.lds, (const char*)FPTR(f16, WS_AO), DM, S, E);
    } SEAM(4);
    if (IN(5)) { p5_norm_route(F, args); } SEAM(5);
    MoeTables MT; MT.pre = nullptr; MT.cnt = nullptr; MT.tmap = nullptr;
    if (IN(6) || IN(7) || IN(8)) moe_tables_build(F, MT);
    if (IN(6)) {
        MoeSched1 S; S.T = MT; S.G = F.G; S.c = (int)blockIdx.x; S.listt = FPTR(int, WS_LISTT); S.Bt = (const char*)FPTR(f16, WS_BT1); S.bexp = (size_t)512 * DM * 2;
        EpiSwiglu E{FPTR(f16, WS_ACT), MT};
        for (int rep = 0; rep < NREP(6); ++rep) gm::gemm_phase<EpiSwiglu, MoeSched1, true>(F.lds, (const char*)FPTR(f16, WS_H), DM, S, E);
    } SEAM(6);
    if (IN(7)) {
        MoeSched2 S; S.T = MT; S.G = F.G; S.c = (int)blockIdx.x; S.listt = nullptr; S.Bt = (const char*)FPTR(f16, WS_BT2); S.bexp = (size_t)DM * DEXP * 2;
        EpiY E{FPTR(f16, WS_Y), FPTR(float, WS_LISTC), MT};
        for (int rep = 0; rep < NREP(7); ++rep) gm::gemm_phase<EpiY, MoeSched2, true>(F.lds, (const char*)FPTR(f16, WS_ACT), DEXP, S, E);
    } SEAM(7);
    if (IN(8)) { p8_combine(F, args, MT); }
#undef IN
#undef SEAM
}

extern "C" void kernel_launch(void* const* d_in, const int* in_sizes, int n_in, void* d_out, int out_size, void* d_ws, size_t ws_size, hipStream_t stream) {
    static int grid = 0;
    if (grid == 0) {
        if (n_in != 21 || out_size != NT * DM || ws_size < WS_END) { fprintf(stderr, "kernel_launch: unexpected problem (n_in %d, out %d, ws %zu < %zu)\n", n_in, out_size, ws_size, (size_t)WS_END); grid = -1; return; }
        int dev = 0, cus = 0, per_cu = 0;
        if (hipGetDevice(&dev) != hipSuccess || hipDeviceGetAttribute(&cus, hipDeviceAttributeMultiprocessorCount, dev) != hipSuccess) { grid = -1; return; }
        if (hipFuncSetAttribute((const void*)fwd, hipFuncAttributeMaxDynamicSharedMemorySize, LDS_BYTES) != hipSuccess) { fprintf(stderr, "kernel_launch: hipFuncSetAttribute failed\n"); grid = -1; return; }
        if (hipOccupancyMaxActiveBlocksPerMultiprocessor(&per_cu, (const void*)fwd, 512, LDS_BYTES) != hipSuccess || per_cu < 1) { fprintf(stderr, "kernel_launch: occupancy query says %d\n", per_cu); }
        (void)hipGetLastError();
        grid = cus & ~3;
        if (grid < 4) grid = 4;
    }
    if (grid < 0) return;
    (void)hipMemsetAsync((char*)d_ws + WS_CTL, 0, CTL_BYTES, stream);
    Args a{};
    a.x = (const float*)d_in[0]; a.c = (const float*)d_in[1]; a.pos = (const int*)d_in[2]; a.w_ada = (const float*)d_in[3]; a.b_ada = (const float*)d_in[4];
    a.g_mix = (const float*)d_in[5]; a.g_ffn = (const float*)d_in[6]; a.w_in = (const float*)d_in[7]; a.g_q = (const float*)d_in[8]; a.g_k = (const float*)d_in[9];
    a.g_kidx = (const float*)d_in[10]; a.w_pool = (const float*)d_in[11]; a.pool_scale = (const float*)d_in[12]; a.w_out = (const float*)d_in[13];
    a.w_rg = (const float*)d_in[14]; a.b_rg = (const float*)d_in[15]; a.w_re = (const float*)d_in[16]; a.b_re = (const float*)d_in[17];
    a.w_gate = (const float*)d_in[18]; a.w_up = (const float*)d_in[19]; a.w_down = (const float*)d_in[20];
    a.out = (float*)d_out; a.ws = (unsigned char*)d_ws;
#if N_LAUNCH_MODE == 1
    a.ph_lo = 0; a.ph_hi = NPH;
    hipLaunchKernelGGL(fwd, dim3(grid), dim3(512), LDS_BYTES, stream, a);
#else
    for (int p = 0; p < NPH; ++p) { a.ph_lo = p; a.ph_hi = p + 1; hipLaunchKernelGGL(fwd, dim3(grid), dim3(512), LDS_BYTES, stream, a); }
#endif
}
```

```cpp
#include <hip/hip_runtime.h>
#include <cstdio>
#include <cstdint>

#ifndef N_LAUNCH_MODE
#define N_LAUNCH_MODE 1
#endif

#ifndef REP_MASK
#define REP_MASK 0
#endif
#define NREP(k) (((REP_MASK >> (k)) & 1) ? 2 : 1)
#define LAS __attribute__((address_space(3)))
typedef _Float16 f16;
typedef _Float16 f16x8 __attribute__((ext_vector_type(8)));
typedef _Float16 f16x4 __attribute__((ext_vector_type(4)));
typedef float f32x4 __attribute__((ext_vector_type(4)));
typedef float f32x16 __attribute__((ext_vector_type(16)));
typedef unsigned short u16;

constexpr int NB = 4, SEQ = 8192, DM = 1024, NT = NB * SEQ;
constexpr int DIN = 1736, NIN = 1792;
constexpr int NEXP = 32, DEXP = 256;
constexpr int TOPK = 256;
constexpr int NPH = 8;
constexpr float EPSN = 1e-6f;
constexpr int MOE_ROWS = 65536 + 32 * 256;

constexpr size_t WS_CTL = 0;
constexpr size_t CTL_BYTES = 65536;
constexpr size_t WS_MODP = WS_CTL + CTL_BYTES;
constexpr size_t WS_MOD = WS_MODP + 16ull * 4 * 6144 * 4;
constexpr size_t WS_WRT = WS_MOD + 4ull * 6144 * 4;
constexpr size_t WS_G3 = WS_WRT + 48ull * 1024 * 4;
constexpr size_t WS_WRH = WS_G3 + 1024;
constexpr size_t WS_WRL = WS_WRH + 48ull * 1024 * 2;
constexpr size_t WS_COS = WS_WRL + 48ull * 1024 * 2;
constexpr size_t WS_SIN = WS_COS + (size_t)NT * 32 * 4;
constexpr size_t WS_BTIN = WS_SIN + (size_t)NT * 32 * 4;
constexpr size_t WS_BTOUT = WS_BTIN + (size_t)NIN * DM * 2;
constexpr size_t WS_BT1 = WS_BTOUT + (size_t)DM * DM * 2;
constexpr size_t WS_BT2 = WS_BT1 + (size_t)NEXP * 512 * DM * 2;
constexpr size_t WS_H = WS_BT2 + (size_t)NEXP * DM * DEXP * 2;
constexpr size_t WS_Q = WS_H + (size_t)NT * DM * 2;
constexpr size_t WS_QI = WS_Q + (size_t)NT * 512 * 2;
constexpr size_t WS_U = WS_QI + (size_t)NT * 512 * 2;
constexpr size_t WS_KV = WS_U + (size_t)NT * 512 * 2;
constexpr size_t WS_KI = WS_KV + (size_t)NT * 128 * 2;
constexpr size_t WS_WI = WS_KI + (size_t)NT * 64 * 2;
constexpr size_t WS_AO = WS_WI + (size_t)NT * 8 * 4;
constexpr size_t WS_TOKROW = WS_AO + (size_t)NT * DM * 2;
constexpr size_t WS_LISTT = WS_TOKROW + (size_t)NT * 2 * 4;
constexpr size_t WS_LISTC = WS_LISTT + (size_t)NEXP * NT * 4;
constexpr size_t WS_X1H = WS_LISTC + (size_t)NEXP * NT * 4;
constexpr int NCLS = 112;
constexpr int MOE2_ROWS = NT + NCLS * 256;
constexpr size_t WS_LISTD = WS_X1H + (size_t)NT * DM * 2;
constexpr size_t WS_TOKR = WS_LISTD + (size_t)NEXP * NT * 4;
constexpr size_t WS_ACT2 = WS_TOKR + (size_t)MOE2_ROWS * 4;
constexpr size_t WS_END = WS_ACT2 + (size_t)MOE2_ROWS * 512 * 2;
constexpr size_t WS_Y = WS_H;
constexpr size_t WS_ACT = WS_AO;
static_assert((size_t)MOE_ROWS * DM * 2 <= WS_KV - WS_H, "Y overlay");
static_assert((size_t)MOE_ROWS * DEXP * 2 <= (size_t)NT * DM * 2, "ACT overlay");
constexpr int CW_BAR = 0;
constexpr int CW_CNT = 4096;
constexpr int CW_CCNT = 4672;
constexpr int CW_P3Q = 4352;

constexpr int LDS_BYTES = 163840;
constexpr int LDS_MISC = LDS_BYTES - 1024;

#define XB_TMO      128
#define XB_XCNT(j)  (256  + 64 * (j))
#define XB_XSUB(j)  (1280 + 64 * (j))
#define XB_XGEN(j)  (2304 + 64 * (j))
#define XB_TOP      3328
#define XB_TOPGEN   3392
#define XCD_BAR_WORDS 3456
#define XB_SPIN_CAP (1u << 18)
__device__ __forceinline__ unsigned xb_ld(unsigned* p)              { return __hip_atomic_load(p, __ATOMIC_RELAXED, __HIP_MEMORY_SCOPE_AGENT); }
__device__ __forceinline__ unsigned xb_add(unsigned* p, unsigned v) { return __hip_atomic_fetch_add(p, v, __ATOMIC_RELAXED, __HIP_MEMORY_SCOPE_AGENT); }
__device__ __forceinline__ unsigned xb_xcc_id() { return (unsigned)__builtin_amdgcn_s_getreg((3 << 11) | 20) & 0xFu; }
#define XB_SPIN(cond, bar) do { unsigned _sp = 0; while (cond) { __builtin_amdgcn_s_sleep(1); \
    if ((++_sp & 255u) == 0u) { if (xb_ld(&(bar)[XB_TMO])) break; if (_sp > XB_SPIN_CAP) { atomicAdd(&(bar)[XB_TMO], 1u); break; } } } } while (0)
struct XcdBarrier { unsigned* bar; unsigned x; volatile LAS unsigned* st; };
__device__ __forceinline__ XcdBarrier xcd_barrier_post(unsigned* bar, volatile LAS unsigned* st) {
    XcdBarrier b; b.bar = bar; b.x = xb_xcc_id(); b.st = st;
    if (threadIdx.x == 0) (void)xb_add(&bar[XB_XCNT(b.x)], 1u);
    return b;
}
__device__ __forceinline__ void xcd_barrier_complete(unsigned* bar, unsigned x, unsigned& nloc, unsigned& nx) {
    const unsigned G = gridDim.x * gridDim.y * gridDim.z;
    unsigned sum, cnt, mine, sp = 0u;
    for (;;) {
        sum = 0u; cnt = 0u; mine = 0u;
#pragma unroll
        for (unsigned j = 0; j < 16; ++j) { const unsigned c = xb_ld(&bar[XB_XCNT(j)]); sum += c; cnt += (c > 0u) ? 1u : 0u; mine = (j == x) ? c : mine; }
        if (sum == G) break;
        __builtin_amdgcn_s_sleep(1);
        if ((++sp & 255u) == 0u) { if (xb_ld(&bar[XB_TMO])) break; if (sp > XB_SPIN_CAP) { atomicAdd(&bar[XB_TMO], 1u); break; } }
    }
    nloc = mine > 0u ? mine : 1u; nx = cnt > 0u ? cnt : 1u;
}
__device__ __forceinline__ void xcd_barrier(const XcdBarrier& b) {
    asm volatile("s_waitcnt vmcnt(0)" ::: "memory");
    __syncthreads();
    if (threadIdx.x == 0) {
        unsigned* bar = b.bar;
        __builtin_amdgcn_s_waitcnt(0);
        unsigned nloc = b.st[0], nx = b.st[1];
        if (nloc == 0u) { xcd_barrier_complete(bar, b.x, nloc, nx); b.st[0] = nloc; b.st[1] = nx; }
        const unsigned old = xb_add(&bar[XB_XSUB(b.x)], 1u);
        const unsigned gen = old / nloc;
        if (old + 1u == (gen + 1u) * nloc) {
            __builtin_amdgcn_fence(__ATOMIC_RELEASE, "agent");
            asm volatile("s_waitcnt vmcnt(0)" ::: "memory");
            const unsigned og = xb_add(&bar[XB_TOP], 1u);
            const unsigned tg = og / nx;
            if (og + 1u == (tg + 1u) * nx) xb_add(&bar[XB_TOPGEN], 1u);
            else XB_SPIN(xb_ld(&bar[XB_TOPGEN]) == tg, bar);
            __builtin_amdgcn_fence(__ATOMIC_ACQUIRE, "agent");
            xb_add(&bar[XB_XGEN(b.x)], 1u);
            asm volatile("s_waitcnt vmcnt(0)" ::: "memory");
        } else {
            XB_SPIN(xb_ld(&bar[XB_XGEN(b.x)]) == gen, bar);
            __builtin_amdgcn_fence(__ATOMIC_ACQUIRE, "agent");
            asm volatile("s_waitcnt vmcnt(0)" ::: "memory");
        }
    }
    __syncthreads();
}

struct Args {
    const float* x; const float* c; const int* pos; const float* w_ada; const float* b_ada; const float* g_mix; const float* g_ffn; const float* w_in;
    const float* g_q; const float* g_k; const float* g_kidx; const float* w_pool; const float* pool_scale; const float* w_out;
    const float* w_rg; const float* b_rg; const float* w_re; const float* b_re; const float* w_gate; const float* w_up; const float* w_down;
    float* out; unsigned char* ws; int ph_lo, ph_hi;
};
struct Frame {
    LAS unsigned char* lds; int tid, lane, wave, G;
    unsigned char* ws;
};
#define FPTR(type, off) ((type*)(F.ws + (off)))

#define DPP_I(v, ctrl, rmask, oldv) __builtin_amdgcn_update_dpp((int)(oldv), (int)(v), (ctrl), (rmask), 0xf, false)
__device__ __forceinline__ float wave_sum(float v) {
    v += __int_as_float(DPP_I(__float_as_int(v), 0x111, 0xf, 0)); v += __int_as_float(DPP_I(__float_as_int(v), 0x112, 0xf, 0));
    v += __int_as_float(DPP_I(__float_as_int(v), 0x114, 0xf, 0)); v += __int_as_float(DPP_I(__float_as_int(v), 0x118, 0xf, 0));
    v += __int_as_float(DPP_I(__float_as_int(v), 0x142, 0xa, 0)); v += __int_as_float(DPP_I(__float_as_int(v), 0x143, 0xc, 0));
    return __int_as_float(__builtin_amdgcn_readlane(__float_as_int(v), 63));
}
__device__ __forceinline__ unsigned wave_min_u(unsigned v) {
    unsigned t;
    t = (unsigned)DPP_I(v, 0x111, 0xf, 0xFFFFFFFFu); v = t < v ? t : v; t = (unsigned)DPP_I(v, 0x112, 0xf, 0xFFFFFFFFu); v = t < v ? t : v;
    t = (unsigned)DPP_I(v, 0x114, 0xf, 0xFFFFFFFFu); v = t < v ? t : v; t = (unsigned)DPP_I(v, 0x118, 0xf, 0xFFFFFFFFu); v = t < v ? t : v;
    t = (unsigned)DPP_I(v, 0x142, 0xa, 0xFFFFFFFFu); v = t < v ? t : v; t = (unsigned)DPP_I(v, 0x143, 0xc, 0xFFFFFFFFu); v = t < v ? t : v;
    return (unsigned)__builtin_amdgcn_readlane((int)v, 63);
}
__device__ __forceinline__ unsigned wave_max_u(unsigned v) {
    unsigned t;
    t = (unsigned)DPP_I(v, 0x111, 0xf, 0u); v = t > v ? t : v; t = (unsigned)DPP_I(v, 0x112, 0xf, 0u); v = t > v ? t : v;
    t = (unsigned)DPP_I(v, 0x114, 0xf, 0u); v = t > v ? t : v; t = (unsigned)DPP_I(v, 0x118, 0xf, 0u); v = t > v ? t : v;
    t = (unsigned)DPP_I(v, 0x142, 0xa, 0u); v = t > v ? t : v; t = (unsigned)DPP_I(v, 0x143, 0xc, 0u); v = t > v ? t : v;
    return (unsigned)__builtin_amdgcn_readlane((int)v, 63);
}
__device__ __forceinline__ float silu_f(float v) { return v / (1.f + __expf(-v)); }

namespace gm {
constexpr int BM = 256, BK = 64, HALF = 128, HTB = HALF * BK * 2, STAGE_BYTES = 8 * HTB;
__device__ __forceinline__ int lds_byte(int r, int c) { const int st = (r >> 4) * 2 + (c >> 5), rr = r & 15, cc = c & 31, ob = rr * 64 + cc * 2; return st * 1024 + (ob ^ (((ob >> 9) & 1) << 5)); }
__device__ __forceinline__ void stage_rc(int b, int& R, int& C) { const int st = b / 1024, sb = b % 1024, swz = sb ^ (((sb >> 9) & 1) << 5); R = (st >> 1) * 16 + swz / 64; C = (st & 1) * 32 + (swz % 64) / 2; }

template <class Epi, class Sched, bool ALIGN_EPI>
__device__ __forceinline__ void gemm_phase(LAS unsigned char* lds, const char* Abase, const int K, const int KB, const Sched& S, const Epi& E) {
    const int tid = threadIdx.x, wid = __builtin_amdgcn_readfirstlane(tid >> 6), lane = tid & 63, wr = wid >> 2, wc = wid & 3, fr = lane & 15, fq = lane >> 4;
    const int nt = K / BK;
    int Rr[2]; unsigned cbA[2], voffB[2];
#pragma unroll
    for (int i = 0; i < 2; ++i) { int R, C; stage_rc(tid * 16 + i * 8192, R, C); Rr[i] = R; cbA[i] = (unsigned)C * 2u; voffB[i] = (unsigned)(R * KB + C) * 2u; }
    const size_t kstep = (size_t)(BK * 2);
    const size_t hstep = (size_t)HALF * K * 2;
    const size_t hstepB = (size_t)HALF * KB * 2;
    const unsigned rowb = (unsigned)K * 2u;
    const unsigned ldsw = (unsigned)wid * 1024u;
    const int aoff = lds_byte(wr * 64 + fr, fq * 8), boff = lds_byte(wc * 32 + fr, fq * 8);
#define GM_SA(b, h) (((b) * 2 + (h)) * HTB)
#define GM_SB(b, h) ((4 + (b) * 2 + (h)) * HTB)
#define GM_STAGE(bufoff, gbase, voff) do { _Pragma("unroll") for (int _i = 0; _i < 2; ++_i) \
        __builtin_amdgcn_global_load_lds((const unsigned*)((const char*)(gbase) + (voff)[_i]), (LAS unsigned*)(lds + (bufoff) + ldsw + _i * 8192), 16, 0, 0); } while (0)
#define GM_LDA(dst, b, h) do { _Pragma("unroll") for (int m = 0; m < 4; ++m) _Pragma("unroll") for (int k = 0; k < 2; ++k) dst[m][k] = *(const LAS f16x8*)(lds + GM_SA(b, h) + aoff + m * 2048 + k * 1024); } while (0)
#define GM_LDB(dst, b, h) do { _Pragma("unroll") for (int n = 0; n < 2; ++n) _Pragma("unroll") for (int k = 0; k < 2; ++k) dst[n][k] = *(const LAS f16x8*)(lds + GM_SB(b, h) + boff + n * 2048 + k * 1024); } while (0)
#define GM_MMA(ai, bj, At, Bt) do { __builtin_amdgcn_s_setprio(1); _Pragma("unroll") for (int m = 0; m < 4; ++m) _Pragma("unroll") for (int n = 0; n < 2; ++n) _Pragma("unroll") for (int k = 0; k < 2; ++k) \
        acc[ai][bj][m][n] = __builtin_amdgcn_mfma_f32_16x16x32_f16(Bt[n][k], At[m][k], acc[ai][bj][m][n], 0, 0, 0); __builtin_amdgcn_s_setprio(0); } while (0)
#define GM_WAIT_V(n) asm volatile("s_waitcnt vmcnt(" #n ")" ::: "memory")
#define GM_WAIT_L(n) asm volatile("s_waitcnt lgkmcnt(" #n ")" ::: "memory")
#define GM_BAR __builtin_amdgcn_s_barrier()
#define GM_SCHED __builtin_amdgcn_sched_barrier(0)
    typename Sched::Unit cur, nxt; int ui = 0;
    if (!S.next(0, cur)) return;
    f32x4 acc[2][2][4][2];
#pragma unroll
    for (int a = 0; a < 2; ++a)
#pragma unroll
        for (int b = 0; b < 2; ++b)
#pragma unroll
            for (int m = 0; m < 4; ++m)
#pragma unroll
                for (int n = 0; n < 2; ++n) acc[a][b][m][n] = (f32x4){0.f, 0.f, 0.f, 0.f};
    f16x8 At[4][2], B0[2][2], B1[2][2];
    constexpr bool GA = Sched::GATHER;
    unsigned vA0[2], vA1[2], vN0[2], vN1[2];
    const char* cA = Abase;
    if constexpr (GA) {
#pragma unroll
        for (int i = 0; i < 2; ++i) { vA0[i] = S.arow(cur, Rr[i]) * rowb + cbA[i]; vA1[i] = S.arow(cur, HALF + Rr[i]) * rowb + cbA[i]; vN0[i] = vA0[i]; vN1[i] = vA1[i]; }
    } else {
#pragma unroll
        for (int i = 0; i < 2; ++i) { vA0[i] = (unsigned)Rr[i] * rowb + cbA[i]; vA1[i] = 0; vN0[i] = 0; vN1[i] = 0; }
        cA = Abase + S.abase(cur);
    }
#define GM_STAGE_A0(bufoff, ptr, o0) GM_STAGE(bufoff, ptr, o0)
#define GM_STAGE_A1(bufoff, ptr, o0, o1) do { if constexpr (GA) { GM_STAGE(bufoff, ptr, o1); } else { GM_STAGE(bufoff, (ptr) + hstep, o0); } } while (0)
    typename Sched::BP cBP = S.bbase(cur), nBP = cBP;
    GM_STAGE(GM_SB(0, 0), S.bat(cBP, 0), voffB); GM_STAGE(GM_SB(0, 1), S.bat(cBP, 0) + hstepB, voffB); GM_STAGE_A0(GM_SA(0, 0), cA, vA0); GM_STAGE_A1(GM_SA(0, 1), cA, vA0, vA1);
    if (wr == 1) GM_BAR;
    GM_WAIT_V(2); GM_BAR;
    GM_STAGE(GM_SB(1, 0), S.bat(cBP, 1), voffB); GM_STAGE_A0(GM_SA(1, 0), cA + kstep, vA0); GM_STAGE(GM_SB(1, 1), S.bat(cBP, 1) + hstepB, voffB);
    GM_WAIT_V(6); GM_BAR;
    for (;;) {
        const bool has_next = S.next(ui + 1, nxt);
        nBP = cBP; const char* nA = cA;
        if constexpr (GA) {
#pragma unroll
            for (int i = 0; i < 2; ++i) { vN0[i] = vA0[i]; vN1[i] = vA1[i]; }
        }
        if (has_next) {
            nBP = S.bbase(nxt);
            if constexpr (GA) {
#pragma unroll
                for (int i = 0; i < 2; ++i) { vN0[i] = S.arow(nxt, Rr[i]) * rowb + cbA[i]; vN1[i] = S.arow(nxt, HALF + Rr[i]) * rowb + cbA[i]; }
            } else nA = Abase + S.abase(nxt);
        }
        for (int t = 0; t < nt; t += 2) {
            const bool last = (t == nt - 2);
            const char* a1 = cA + (size_t)(t + 1) * kstep;
            const char* a2 = last ? nA : cA + (size_t)(t + 2) * kstep; const char* b2 = last ? S.bat(nBP, 0) : S.bat(cBP, t + 2);
            const char* a3 = a2 + kstep; const char* b3 = last ? S.bat(nBP, 1) : S.bat(cBP, t + 3);
            unsigned w0[2], w1[2];
#pragma unroll
            for (int i = 0; i < 2; ++i) { w0[i] = (GA && last) ? vN0[i] : vA0[i]; w1[i] = (GA && last) ? vN1[i] : vA1[i]; }
            GM_LDB(B0, 0, 0); GM_LDB(B1, 0, 1); GM_SCHED; GM_LDA(At, 0, 0); GM_STAGE_A1(GM_SA(1, 1), a1, vA0, vA1);
            GM_WAIT_V(8); GM_WAIT_L(0); GM_BAR; GM_MMA(0, 0, At, B0); GM_MMA(0, 1, At, B1); GM_BAR; GM_SCHED;
            GM_LDA(At, 0, 1); GM_STAGE(GM_SB(0, 0), b2, voffB); GM_STAGE(GM_SB(0, 1), b2 + hstepB, voffB); GM_STAGE_A0(GM_SA(0, 0), a2, w0);
            GM_WAIT_V(8); GM_WAIT_L(0); GM_BAR; GM_MMA(1, 0, At, B0); GM_MMA(1, 1, At, B1); GM_BAR; GM_SCHED;
            GM_LDB(B0, 1, 0); GM_LDB(B1, 1, 1); GM_SCHED; GM_LDA(At, 1, 0); GM_STAGE_A1(GM_SA(0, 1), a2, w0, w1);
            GM_WAIT_V(8); GM_WAIT_L(0); GM_BAR; GM_MMA(0, 0, At, B0); GM_MMA(0, 1, At, B1); GM_BAR; GM_SCHED;
            GM_LDA(At, 1, 1); GM_STAGE(GM_SB(1, 0), b3, voffB); GM_STAGE(GM_SB(1, 1), b3 + hstepB, voffB); GM_STAGE_A0(GM_SA(1, 0), a3, w0);
            GM_WAIT_V(8); GM_WAIT_L(0); GM_BAR; GM_MMA(1, 0, At, B0); GM_MMA(1, 1, At, B1); GM_BAR; GM_SCHED;
        }
        if constexpr (ALIGN_EPI) { if (wr == 0) GM_BAR; }
        E(acc, cur, wr, wc, fr, fq);
        if (!has_next) break;
#pragma unroll
        for (int a = 0; a < 2; ++a)
#pragma unroll
            for (int b = 0; b < 2; ++b)
#pragma unroll
                for (int m = 0; m < 4; ++m)
#pragma unroll
                    for (int n = 0; n < 2; ++n) acc[a][b][m][n] = (f32x4){0.f, 0.f, 0.f, 0.f};
        cur = nxt; cBP = nBP; cA = nA; ++ui;
        if constexpr (GA) {
#pragma unroll
            for (int i = 0; i < 2; ++i) { vA0[i] = vN0[i]; vA1[i] = vN1[i]; }
        }
        if constexpr (ALIGN_EPI) { if (wr == 1) GM_BAR; }
    }
    GM_WAIT_V(0);
    if constexpr (!ALIGN_EPI) { if (wr == 0) GM_BAR; }
    GM_BAR;
#undef GM_SA
#undef GM_SB
#undef GM_STAGE
#undef GM_STAGE_A0
#undef GM_STAGE_A1
#undef GM_LDA
#undef GM_LDB
#undef GM_MMA
#undef GM_WAIT_V
#undef GM_WAIT_L
#undef GM_BAR
#undef GM_SCHED
}

struct DenseSched {
    static constexpr bool GATHER = false;
    struct Unit { int pm, pn; };
    int nM, nN, nwg, G, c, K; const char* Bt;
    __device__ void init(int M, int N, int K_, int G_, int c_, const void* Bt_) { nM = M / BM; nN = N / BM; nwg = nM * nN; G = G_; c = c_; K = K_; Bt = (const char*)Bt_; }
    __device__ __forceinline__ bool next(int i, Unit& u) const {
        const long L = (long)i * G + c; if (L >= nwg) return false;
        int wgid = (int)L; { const int q = nwg / 8, r = nwg % 8, xcd = wgid % 8, off = wgid / 8; wgid = (xcd < r ? xcd * (q + 1) : r * (q + 1) + (xcd - r) * q) + off; }
        const int nig = 8 * nN, gid = wgid / nig, fm = gid * 8, gsz = (nM - fm) < 8 ? (nM - fm) : 8;
        u.pm = fm + ((wgid % nig) % gsz); u.pn = (wgid % nig) / gsz; return true;
    }
    __device__ __forceinline__ unsigned arow(const Unit& u, int r) const { return (unsigned)(u.pm * BM + r); }
    __device__ __forceinline__ size_t abase(const Unit& u) const { return (size_t)u.pm * BM * K * 2; }
    struct BP { const char* p; };
    __device__ __forceinline__ BP bbase(const Unit& u) const { return BP{Bt + (size_t)u.pn * BM * K * 2}; }
    __device__ __forceinline__ const char* bat(const BP& b, int t) const { return b.p + (size_t)t * (BK * 2); }
};
}

__device__ __forceinline__ int prow32(int c) { return (c & ~31) | (((c >> 2) & 1) << 4) | (((c >> 3) & 3) << 2) | (c & 3); }
__device__ __forceinline__ int colmap_in(int n) {
    const int pn = n >> 8, r = n & 255, bj = r >> 7, wc = (r >> 5) & 3, i = (((r >> 2) & 3) << 3) | (((r >> 4) & 1) << 2) | (r & 3);
    if (pn < 2) return (4 * pn + wc) * 64 + bj * 32 + i;
    if (pn < 4) return 640 + (4 * (pn - 2) + wc) * 64 + bj * 32 + i;
    if (pn == 4) {
        if (wc == 0) return 512 + bj * 32 + i;
        if (wc == 1) return 1152 + bj * 32 + i;
        if (wc == 2) return 576 + bj * 32 + i;
        return (bj == 0 && i < 8) ? 1216 + i : -1;
    }
    return 1224 + (pn - 5) * 256 + (r & ~31) + i;
}

template <class ColF>
__device__ __forceinline__ void transpose_tile(const Frame& F, const float* src, int lds_, f16* dst, int ldd, int k0, int n0, ColF colf) {
    LAS float* tile = (LAS float*)F.lds;
    const int n4 = (F.tid & 15) * 4, kq = F.tid >> 4;
    const int col = colf(n0 + n4);
#pragma unroll
    for (int rep = 0; rep < 2; ++rep) {
        const int kk = kq + 32 * rep;
        f32x4 v = {0.f, 0.f, 0.f, 0.f};
        if (col >= 0) v = *(const f32x4*)(src + (size_t)(k0 + kk) * lds_ + col);
#pragma unroll
        for (int e = 0; e < 4; ++e) tile[kk * 65 + n4 + e] = v[e];
    }
    __syncthreads();
    const int nr = F.tid >> 3, kc = (F.tid & 7) * 8;
    f16x8 o;
#pragma unroll
    for (int j = 0; j < 8; ++j) o[j] = (f16)tile[(kc + j) * 65 + nr];
    *(f16x8*)(dst + (size_t)(n0 + nr) * ldd + k0 + kc) = o;
    __syncthreads();
}

__device__ __forceinline__ void p0_prologue(const Frame& F, const Args& a) {
    const int gid = blockIdx.x * 512 + F.tid, gsz = F.G * 512;
    {
        LAS float* ca = (LAS float*)F.lds;
        for (int i = F.tid; i < 4096; i += 512) ca[i] = silu_f(a.c[i]);
        __syncthreads();
        for (int id = gid; id < 16 * 6144; id += gsz) {
            const int kc = id / 6144, n = id - kc * 6144;
            float s0 = 0.f, s1 = 0.f, s2 = 0.f, s3 = 0.f;
#pragma unroll 32
            for (int k = kc * 64; k < kc * 64 + 64; ++k) { const float w = a.w_ada[(size_t)k * 6144 + n]; s0 += ca[k] * w; s1 += ca[1024 + k] * w; s2 += ca[2048 + k] * w; s3 += ca[3072 + k] * w; }
            float* mp = FPTR(float, WS_MODP) + (size_t)kc * 4 * 6144 + n;
            mp[0] = s0; mp[6144] = s1; mp[2 * 6144] = s2; mp[3 * 6144] = s3;
        }
        __syncthreads();
    }
    {
        const float inv = (float)pow(10000.0, -(double)(2 * (gid & 31)) / 64.0);
        for (int id = gid; id < NT * 32; id += gsz) {
            const int t = id >> 5;
            const float ang = (float)a.pos[t] * inv;
            const double rev = (double)ang * 0.15915494309189535;
            const float fr = (float)(rev - rint(rev));
            FPTR(float, WS_COS)[id] = __builtin_amdgcn_cosf(fr); FPTR(float, WS_SIN)[id] = __builtin_amdgcn_sinf(fr);
        }
    }
    if (gid < 192) ((float*)(a.ws + WS_G3))[gid] = gid < 64 ? a.g_q[gid] : (gid < 128 ? a.g_k[gid - 64] : a.g_kidx[gid - 128]);
    for (int id = gid; id < 48 * 1024; id += gsz) { const int o = id >> 10, k = id & 1023; const float w = o < 4 ? a.w_rg[k * 4 + o] : (o < 36 ? a.w_re[k * 32 + (o - 4)] : 0.f);
        FPTR(float, WS_WRT)[id] = w; const f16 hi = (f16)w; FPTR(f16, WS_WRH)[id] = hi; FPTR(f16, WS_WRL)[id] = (f16)((w - (float)hi) * 2048.f); }
    constexpr int NT_FOLD = 256, NT_IN = 28 * 16, NT_OUT = 16 * 8, NT_G = 32 * 8 * 16, NT_D = 32 * 16 * 4;
    constexpr int NTASK = NT_FOLD + NT_IN + NT_OUT + NT_G + NT_D;
    for (int task = blockIdx.x; task < NTASK; task += F.G) {
        int tk = task;
        if (tk < NT_FOLD) {
            const int g = tk >> 6, cch = (tk >> 4) & 3, nb = tk & 15, n = nb * 64 + (F.tid & 63), cg = F.tid >> 6;
            LAS float* wps = (LAS float*)F.lds;
            for (int i = F.tid; i < 32 * 128; i += 512) wps[i] = a.w_pool[(size_t)(g * 128 + cch * 32) * 128 + i];
            if (F.tid < 128) wps[4096 + F.tid] = a.pool_scale[g * 128 + F.tid];
            __syncthreads();
            float accv[4] = {0.f, 0.f, 0.f, 0.f};
#pragma unroll 4
            for (int d = 0; d < 128; d += 4) {
                f32x4 wo; const f32x4 ps = *(const LAS f32x4*)(wps + 4096 + d);
#pragma unroll
                for (int e = 0; e < 4; ++e) wo[e] = a.w_out[(size_t)(512 + g * 128 + d + e) * DM + n] * ps[e];
#pragma unroll
                for (int c = 0; c < 4; ++c) { const f32x4 w4 = *(const LAS f32x4*)(wps + (cg * 4 + c) * 128 + d); accv[c] += w4[0] * wo[0] + w4[1] * wo[1] + w4[2] * wo[2] + w4[3] * wo[3]; }
            }
            __syncthreads();
            { f16x4 o;
#pragma unroll
              for (int c = 0; c < 4; ++c) o[c] = (f16)accv[c];
              *(f16x4*)(FPTR(f16, WS_BTOUT) + (size_t)prow32(n) * DM + 512 + g * 128 + cch * 32 + cg * 4) = o; }
            continue;
        }
        break;
    }
    {
        LAS float* tile = (LAS float*)F.lds;
        const int n4 = (F.tid & 15) * 4, kq = F.tid >> 4, nr = F.tid >> 3, kc = (F.tid & 7) * 8;
        struct TD { const float* src; f16* dst; int lds_, ldd, k0, n0, col, tc; };
        auto decode = [&](int task, TD& d) -> bool {
            int tk = task - NT_FOLD;
            if (tk < 0 || task >= NTASK) return false;
            if (tk < NT_IN) { d.src = a.w_in; d.lds_ = DIN; d.dst = FPTR(f16, WS_BTIN); d.ldd = DM; d.k0 = (tk & 15) * 64; d.n0 = (tk >> 4) * 64; d.col = colmap_in(d.n0 + n4); d.tc = n4; return true; }
            tk -= NT_IN;
            if (tk < NT_OUT) { d.src = a.w_out; d.lds_ = DM; d.dst = FPTR(f16, WS_BTOUT); d.ldd = DM; d.k0 = (tk & 7) * 64; d.n0 = (tk >> 3) * 64; d.col = d.n0 + n4; d.tc = prow32(n4); return true; }
            tk -= NT_OUT;
            if (tk < NT_G) {
                const int e = tk >> 7, r0 = ((tk >> 4) & 7) * 64, bj = (r0 & 255) >> 7;
                d.src = (bj ? a.w_up : a.w_gate) + (size_t)e * DM * DEXP; d.lds_ = DEXP; d.dst = FPTR(f16, WS_BT1) + (size_t)e * 512 * DM; d.ldd = DM; d.k0 = (tk & 15) * 64; d.n0 = r0;
                d.col = (r0 >> 8) * 128 + (r0 & 127) + n4; d.tc = prow32(n4); return true; }
            tk -= NT_G;
            { const int e = tk >> 6; d.src = a.w_down + (size_t)e * DEXP * DM; d.lds_ = DM; d.dst = FPTR(f16, WS_BT2) + (size_t)e * DM * DEXP; d.ldd = DEXP; d.k0 = (tk & 3) * 64; d.n0 = ((tk >> 2) & 15) * 64; d.col = d.n0 + n4; d.tc = prow32(n4); }
            return true;
        };
        int task = blockIdx.x; while (task < NT_FOLD) task += F.G;
        TD cur; bool have = decode(task, cur);
        f32x4 v0 = {0.f, 0.f, 0.f, 0.f}, v1 = v0;
        if (have && cur.col >= 0) { v0 = *(const f32x4*)(cur.src + (size_t)(cur.k0 + kq) * cur.lds_ + cur.col); v1 = *(const f32x4*)(cur.src + (size_t)(cur.k0 + kq + 32) * cur.lds_ + cur.col); }
        while (have) {
            TD nxt; const bool hn = decode(task + F.G, nxt);
            f32x4 w0 = {0.f, 0.f, 0.f, 0.f}, w1 = w0;
            if (hn && nxt.col >= 0) { w0 = *(const f32x4*)(nxt.src + (size_t)(nxt.k0 + kq) * nxt.lds_ + nxt.col); w1 = *(const f32x4*)(nxt.src + (size_t)(nxt.k0 + kq + 32) * nxt.lds_ + nxt.col); }
#pragma unroll
            for (int e = 0; e < 4; ++e) { tile[kq * 65 + cur.tc + e] = v0[e]; tile[(kq + 32) * 65 + cur.tc + e] = v1[e]; }
            __syncthreads();
            f16x8 o;
#pragma unroll
            for (int j = 0; j < 8; ++j) o[j] = (f16)tile[(kc + j) * 65 + nr];
            *(f16x8*)(cur.dst + (size_t)(cur.n0 + nr) * cur.ldd + cur.k0 + kc) = o;
            __syncthreads();
            cur = nxt; have = hn; v0 = w0; v1 = w1; task += F.G;
        }
    }
}

__device__ __forceinline__ void p1_norm(const Frame& F, const Args& a) {
    LAS float* gs = (LAS float*)F.lds; LAS float* sh = gs + 1024;
    for (int id = blockIdx.x * 512 + F.tid; id < 4 * 6144; id += F.G * 512) {
        float s = a.b_ada[id % 6144];
#pragma unroll
        for (int kc = 0; kc < 16; ++kc) s += FPTR(float, WS_MODP)[(size_t)kc * 4 * 6144 + id];
        FPTR(float, WS_MOD)[id] = s;
    }
    int curb = -1;
    for (int rb = blockIdx.x; rb < NT / 128; rb += F.G) {
        const int b = (rb * 128) / SEQ;
        if (b != curb) {
            __syncthreads();
            for (int cidx = F.tid; cidx < 1024; cidx += 512) {
                float s1 = a.b_ada[cidx], s2 = a.b_ada[1024 + cidx];
#pragma unroll
                for (int kc = 0; kc < 16; ++kc) { s1 += FPTR(float, WS_MODP)[(size_t)(kc * 4 + b) * 6144 + cidx]; s2 += FPTR(float, WS_MODP)[(size_t)(kc * 4 + b) * 6144 + 1024 + cidx]; }
                sh[cidx] = s1; gs[cidx] = a.g_mix[cidx] * (1.f + s2);
            }
            __syncthreads();
            curb = b;
        }
        for (int rq = 0; rq < 4; ++rq) {
            f32x4 v[4][4]; float ss[4];
#pragma unroll
            for (int r = 0; r < 4; ++r) {
                const float* xr = a.x + ((size_t)rb * 128 + F.wave * 16 + rq * 4 + r) * DM;
                ss[r] = 0.f;
#pragma unroll
                for (int j = 0; j < 4; ++j) v[r][j] = *(const f32x4*)(xr + 256 * j + 4 * F.lane);
            }
#pragma unroll
            for (int r = 0; r < 4; ++r) {
#pragma unroll
                for (int j = 0; j < 4; ++j) ss[r] += v[r][j][0] * v[r][j][0] + v[r][j][1] * v[r][j][1] + v[r][j][2] * v[r][j][2] + v[r][j][3] * v[r][j][3];
                ss[r] = wave_sum(ss[r]);
            }
#pragma unroll
            for (int r = 0; r < 4; ++r) {
                const size_t t = (size_t)rb * 128 + F.wave * 16 + rq * 4 + r;
                const float rs = rsqrtf(ss[r] * (1.f / 1024.f) + EPSN);
#pragma unroll
                for (int j = 0; j < 4; ++j) {
                    const int c0 = 256 * j + 4 * F.lane; f16x4 o;
#pragma unroll
                    for (int e = 0; e < 4; ++e) o[e] = (f16)(v[r][j][e] * rs * gs[c0 + e] + sh[c0 + e]);
                    *(f16x4*)(FPTR(f16, WS_H) + t * DM + c0) = o;
                }
            }
        }
    }
}

struct EpiIn {
    unsigned char* ws;
    __device__ __forceinline__ void operator()(const f32x4 (&acc)[2][2][4][2], const gm::DenseSched::Unit& u, int wr, int wc, int fr, int fq) const {
        asm volatile("" : "+v"(fr), "+v"(fq));
        const int pn = u.pn;
        if (pn >= 5) {
#pragma unroll
            for (int ai = 0; ai < 2; ++ai)
#pragma unroll
                for (int m = 0; m < 4; ++m) {
                    const size_t t = (size_t)u.pm * 256 + ai * 128 + wr * 64 + m * 16 + fr;
#pragma unroll
                    for (int bj = 0; bj < 2; ++bj) { f16x8 o;
_Pragma("unroll") for (int n = 0; n < 2; ++n) _Pragma("unroll") for (int e = 0; e < 4; ++e) o[n * 4 + e] = (f16)acc[ai][bj][m][n][e];
                        *(f16x8*)((f16*)(ws + WS_U) + t * 512 + (pn - 5) * 256 + bj * 128 + wc * 32 + fq * 8) = o; }
                }
            return;
        }
        if (pn == 4 && wc >= 2) {
            if (wc == 2) {
#pragma unroll
                for (int ai = 0; ai < 2; ++ai)
#pragma unroll
                    for (int m = 0; m < 4; ++m) {
                        const size_t t = (size_t)u.pm * 256 + ai * 128 + wr * 64 + m * 16 + fr;
#pragma unroll
                        for (int bj = 0; bj < 2; ++bj) { f16x8 o;
_Pragma("unroll") for (int n = 0; n < 2; ++n) _Pragma("unroll") for (int e = 0; e < 4; ++e) o[n * 4 + e] = (f16)acc[ai][bj][m][n][e];
                            *(f16x8*)((f16*)(ws + WS_KV) + t * 128 + 64 + bj * 32 + fq * 8) = o; }
                    }
            } else if (fq == 0) {
#pragma unroll
                for (int ai = 0; ai < 2; ++ai)
#pragma unroll
                    for (int m = 0; m < 4; ++m) {
                        const size_t t = (size_t)u.pm * 256 + ai * 128 + wr * 64 + m * 16 + fr;
                        *(f32x4*)((float*)(ws + WS_WI) + t * 8) = acc[ai][0][m][0] * 0.044194173824159216f;
                        *(f32x4*)((float*)(ws + WS_WI) + t * 8 + 4) = acc[ai][0][m][1] * 0.044194173824159216f;
                    }
            }
            return;
        }
        const bool isq = pn < 2, isqi = (pn == 2 || pn == 3), isk = (pn == 4 && wc == 0);
        const float* gv = (const float*)(ws + WS_G3) + (isq ? 0 : (isk ? 64 : 128));
        const bool donorm = !isqi;
        const float oscale = isq ? 0.125f : 1.f;
        f32x4 g1[2], g2[2];
#pragma unroll
        for (int n = 0; n < 2; ++n) { g1[n] = *(const f32x4*)(gv + fq * 8 + n * 4) * oscale; g2[n] = *(const f32x4*)(gv + 32 + fq * 8 + n * 4) * oscale; }
        if (!donorm) {
#pragma unroll
            for (int n = 0; n < 2; ++n) { g1[n] = (f32x4){1.f, 1.f, 1.f, 1.f}; g2[n] = g1[n]; } }
        const size_t doff = isq ? WS_Q : (isqi ? WS_QI : (isk ? WS_KV : WS_KI));
        f16* dst = (f16*)(ws + doff);
        const int ld = (isq || isqi) ? 512 : (isk ? 128 : 64);
        const int hoff = isq ? (4 * pn + wc) * 64 : (isqi ? (4 * (pn - 2) + wc) * 64 : 0);
        const float* COSp = (const float*)(ws + WS_COS); const float* SINp = (const float*)(ws + WS_SIN);
#pragma unroll
        for (int ai = 0; ai < 2; ++ai) {
            f32x4 cs[4][2], sn[4][2];
#pragma unroll
            for (int m = 0; m < 4; ++m) {
                const size_t t = (size_t)u.pm * 256 + ai * 128 + wr * 64 + m * 16 + fr;
#pragma unroll
                for (int n = 0; n < 2; ++n) { cs[m][n] = *(const f32x4*)(COSp + t * 32 + fq * 8 + n * 4); sn[m][n] = *(const f32x4*)(SINp + t * 32 + fq * 8 + n * 4); }
            }
#pragma unroll
            for (int m = 0; m < 4; ++m) {
                const size_t t = (size_t)u.pm * 256 + ai * 128 + wr * 64 + m * 16 + fr;
                float rs = 1.f;
                if (donorm) {
                    float ss = 0.f;
#pragma unroll
                    for (int bj = 0; bj < 2; ++bj)
#pragma unroll
                        for (int n = 0; n < 2; ++n)
#pragma unroll
                            for (int e = 0; e < 4; ++e) ss += acc[ai][bj][m][n][e] * acc[ai][bj][m][n][e];
                    ss += __shfl_xor(ss, 16); ss += __shfl_xor(ss, 32);
                    rs = rsqrtf(ss * (1.f / 64.f) + EPSN);
                }
                f16x8 o1, o2;
#pragma unroll
                for (int n = 0; n < 2; ++n)
#pragma unroll
                    for (int e = 0; e < 4; ++e) {
                        const float y1 = acc[ai][0][m][n][e] * rs * g1[n][e], y2 = acc[ai][1][m][n][e] * rs * g2[n][e];
                        o1[n * 4 + e] = (f16)(y1 * cs[m][n][e] - y2 * sn[m][n][e]); o2[n * 4 + e] = (f16)(y1 * sn[m][n][e] + y2 * cs[m][n][e]);
                    }
                *(f16x8*)(dst + t * ld + hoff + fq * 8) = o1;
                *(f16x8*)(dst + t * ld + hoff + 32 + fq * 8) = o2;
            }
        }
    }
};

constexpr int CAP = 960;
constexpr int P3_RING = 32768;
constexpr int P3_QB = CAP * 4;
constexpr int P3_WAVE_LDS = 4 * P3_QB;
static_assert(P3_RING + 8 * P3_WAVE_LDS <= LDS_MISC, "P3 LDS");
static_assert(P3_QB >= 1024 + 2048, "a query buffer holds its final 256-word list plus a 2 KiB piece of the V staging");

__device__ __forceinline__ unsigned fkey(float f) { const unsigned u = __float_as_uint(f); return u ^ ((u >> 31) ? 0xFFFFFFFFu : 0x80000000u); }
__device__ __forceinline__ float fkey_inv(unsigned k) { const unsigned u = (k & 0x80000000u) ? (k ^ 0x80000000u) : ~k; return __uint_as_float(u); }
__device__ __forceinline__ unsigned pack_cand(float s, int key) { return (fkey(s) & 0xFFFFE000u) | (8191u - (unsigned)key); }
__device__ __forceinline__ float pack_floor(unsigned w) { return fkey_inv(w & 0xFFFFE000u); }
__device__ __forceinline__ int mbcnt64(unsigned long long m) { return __builtin_amdgcn_mbcnt_hi((unsigned)(m >> 32), __builtin_amdgcn_mbcnt_lo((unsigned)m, 0)); }

template <int NJ>
__device__ __forceinline__ unsigned select_exact_n(LAS unsigned* buf, const int n, const int K, const int lane) {
    unsigned uk[NJ];
    unsigned lmin = 0xFFFFFFFFu, lmax = 0u;
#pragma unroll
    for (int j = 0; j < NJ; ++j) {
        const int p = j * 64 + lane; const unsigned w = buf[p];
        uk[j] = p < n ? w : 0u;
        if (p < n) { lmin = w < lmin ? w : lmin; lmax = w > lmax ? w : lmax; }
    }
    const unsigned umin = wave_min_u(lmin), umax = wave_max_u(lmax);
    const int hb = 31 - __builtin_clz(umin ^ umax);
    unsigned T = (hb == 31) ? 0u : (umax & ~((2u << hb) - 1u));
    int cT = n;
    for (int bit = hb; bit >= 0 && cT != K; --bit) {
        const unsigned cand = T | (1u << bit);
        int c = 0;
#pragma unroll
        for (int j = 0; j < NJ; ++j) c += __builtin_popcountll(__ballot(uk[j] >= cand));
        if (c >= K) { T = cand; cT = c; }
    }
    int wbase = 0; unsigned kmin = 0xFFFFFFFFu;
#pragma unroll
    for (int j = 0; j < NJ; ++j) {
        const bool keep = uk[j] >= T && uk[j] != 0u;
        const unsigned long long km = __ballot(keep);
        const int np = wbase + mbcnt64(km); wbase += __builtin_popcountll(km);
        if (keep) { buf[np] = uk[j]; kmin = uk[j] < kmin ? uk[j] : kmin; }
    }
    return wave_min_u(kmin);
}
__device__ __forceinline__ unsigned select_exact(LAS unsigned* buf, const int n, const int K, const int lane) {
    if (n <= 384) return select_exact_n<6>(buf, n, K, lane);
    if (n <= 640) return select_exact_n<10>(buf, n, K, lane);
    return select_exact_n<CAP / 64>(buf, n, K, lane);
}

__device__ __forceinline__ unsigned prune_fast(LAS unsigned* buf, const int n, const int lane, int& ncnt) {
    constexpr int NJ = CAP / 64;
    unsigned uk[NJ];
#pragma unroll
    for (int j = 0; j < NJ; ++j) { const int p = j * 64 + lane; const unsigned w = buf[p]; uk[j] = p < n ? w : 0u; }
    const unsigned v = buf[(lane * n) >> 6];
    const unsigned smin = wave_min_u(v), smax = wave_max_u(v);
    int rs = (64 * (TOPK + 128)) / n; rs = rs < 4 ? 4 : (rs > 60 ? 60 : rs);
    unsigned T = smax;
    if (smin != smax) {
        const int hb = 31 - __builtin_clz(smin ^ smax);
        T = (hb == 31) ? 0u : (smax & ~((2u << hb) - 1u));
        int it = 0;
        for (int bit = hb; bit >= 0 && it < 18; --bit, ++it) {
            const unsigned cand = T | (1u << bit);
            if (__builtin_popcountll(__ballot(v >= cand)) >= rs) T = cand;
        }
    }
    int call = 0;
#pragma unroll
    for (int j = 0; j < NJ; ++j) call += __builtin_popcountll(__ballot(uk[j] >= T && uk[j] != 0u));
    if (call < TOPK || call > TOPK + 288) { ncnt = TOPK; return select_exact(buf, n, TOPK, lane); }
    int wbase = 0;
#pragma unroll
    for (int j = 0; j < NJ; ++j) {
        const bool keep = uk[j] >= T && uk[j] != 0u;
        const unsigned long long km = __ballot(keep);
        const int np = wbase + mbcnt64(km); wbase += __builtin_popcountll(km);
        if (keep) buf[np] = uk[j];
    }
    ncnt = call;
    return T;
}

__device__ __forceinline__ f16x4 tr_read(unsigned lds_addr) { f16x4 r; asm volatile("ds_read_b64_tr_b16 %0, %1\n\ts_waitcnt lgkmcnt(0)" : "=&v"(r) : "v"(lds_addr) : "memory"); return r; }

template <int WIN>
__device__ __forceinline__ void p3_pool_body(const f16* U, f16* AO, const int t0, const int s0, const int c8) {
    f16x8 R[WIN - 1 + 16];
#pragma unroll
    for (int k = 0; k < WIN - 1 + 16; ++k) {
        R[k] = (f16x8){0, 0, 0, 0, 0, 0, 0, 0};
        if (s0 - (WIN - 1) + k >= 0) R[k] = *(const f16x8*)(U + (size_t)(t0 - (WIN - 1) + k) * 512 + c8);
    }
    float S[8];
#pragma unroll
    for (int e = 0; e < 8; ++e) S[e] = 0.f;
#pragma unroll
    for (int k = 0; k < WIN - 1; ++k)
#pragma unroll
        for (int e = 0; e < 8; ++e) S[e] += (float)R[k][e];
#pragma unroll
    for (int i = 0; i < 16; ++i) {
        const int sp = s0 + i;
        const int nw = (sp + 1) < WIN ? (sp + 1) : WIN;
        const float inv = 1.f / (float)nw; f16x8 o;
#pragma unroll
        for (int e = 0; e < 8; ++e) { S[e] += (float)R[WIN - 1 + i][e]; o[e] = (f16)(S[e] * inv - (float)R[WIN - 1 + i][e]); }
        *(f16x8*)(AO + (size_t)(t0 + i) * DM + 512 + c8) = o;
#pragma unroll
        for (int e = 0; e < 8; ++e) S[e] -= (float)R[i][e];
    }
}
__device__ __forceinline__ void p3_pool(const Frame& F, const int chunk) {
    const f16* U = FPTR(f16, WS_U); f16* AO = FPTR(f16, WS_AO);
    const int g = F.wave & 3, tblk = chunk * 8 + (F.wave >> 2) * 4 + (F.lane >> 4), c8 = g * 128 + (F.lane & 15) * 8;
    const int t0 = tblk * 16, s0 = t0 & (SEQ - 1);
    if (g == 0) p3_pool_body<2>(U, AO, t0, s0, c8);
    else if (g == 1) p3_pool_body<4>(U, AO, t0, s0, c8);
    else if (g == 2) p3_pool_body<8>(U, AO, t0, s0, c8);
    else p3_pool_body<16>(U, AO, t0, s0, c8);
}

#define P3_BAR() do { asm volatile("s_waitcnt lgkmcnt(0)" ::: "memory"); __builtin_amdgcn_s_barrier(); asm volatile("" ::: "memory"); } while (0)
__device__ __forceinline__ void tr_read8(unsigned ad, f16x4 (&v)[8]) {
    asm volatile("ds_read_b64_tr_b16 %0, %8\n\tds_read_b64_tr_b16 %1, %8 offset:3840\n\t"
                 "ds_read_b64_tr_b16 %2, %8 offset:32\n\tds_read_b64_tr_b16 %3, %8 offset:3872\n\t"
                 "ds_read_b64_tr_b16 %4, %8 offset:64\n\tds_read_b64_tr_b16 %5, %8 offset:3904\n\t"
                 "ds_read_b64_tr_b16 %6, %8 offset:96\n\tds_read_b64_tr_b16 %7, %8 offset:3936\n\t"
                 "s_waitcnt lgkmcnt(0)"
                 : "=&v"(v[0]), "=&v"(v[1]), "=&v"(v[2]), "=&v"(v[3]), "=&v"(v[4]), "=&v"(v[5]), "=&v"(v[6]), "=&v"(v[7]) : "v"(ad) : "memory");
}

__device__ __forceinline__ void p3_dsa(const Frame& F) {
    const int lane = F.lane, wid = F.wave, half = lane >> 5, c31 = lane & 31;
    LAS unsigned char* wl = F.lds + P3_RING + wid * P3_WAVE_LDS;
    LAS unsigned* cb = (LAS unsigned*)wl;
    volatile LAS unsigned* flg = (volatile LAS unsigned*)(F.lds + LDS_MISC + 64);
    const int nwgb = F.G >> 2;
    const int b0 = blockIdx.x & 3, wgb = blockIdx.x >> 2;
    const int qq = 2 * ((c31 >> 2) & 1) + (c31 >> 4), hd = (c31 & 3) + 4 * ((c31 >> 3) & 1);
    const int drow = 8 * wid + (lane >> 3), dpart = (lane & 7) ^ ((drow >> 1) & 7);
    unsigned boff[4];
#pragma unroll
    for (int ks = 0; ks < 4; ++ks) boff[ks] = (unsigned)(c31 * 128 + (((2 * ks + half) ^ ((c31 >> 1) & 7)) << 4));
    constexpr int WMARK = CAP - 128;
    unsigned* uctr = FPTR(unsigned, WS_CTL) + CW_P3Q;
    int ucode = (b0 << 16) | wgb;
    while (ucode >= 0) {
        const int b = ucode >> 16, posr = ucode & 0xFFFF;
        const size_t tb = (size_t)b * SEQ;
        const f16* dsrc = FPTR(f16, WS_KI) + (tb + drow) * 64 + dpart * 8;
        const int T0 = (SEQ / 32 - 1 - posr) * 32;
        const int t0 = T0 + 4 * wid;
        const int nstage = (T0 + 31) / 128 + 1;
        P3_BAR();
        if (F.tid < 3) flg[F.tid] = 0u;
        if (F.tid == 0) {
            int code = -1;
            for (int k = 0; k < 4 && code < 0; ++k) { const int bb = (b0 + k) & 3; const unsigned n = atomicAdd(uctr + 64 * bb, 1u) + (unsigned)nwgb; if (n < (unsigned)(SEQ / 32)) code = (bb << 16) | (int)n; }
            flg[4] = (unsigned)code;
        }
        __builtin_amdgcn_global_load_lds((const unsigned*)(dsrc), (LAS unsigned*)(F.lds + wid * 1024), 16, 0, 0);
        __builtin_amdgcn_global_load_lds((const unsigned*)(dsrc + (size_t)64 * 64), (LAS unsigned*)(F.lds + 8192 + wid * 1024), 16, 0, 0);
        f16x8 Af[4];
        { const f16* qip = FPTR(f16, WS_QI) + (tb + t0 + qq) * 512 + hd * 64 + 8 * half;
#pragma unroll
          for (int s4 = 0; s4 < 4; ++s4) Af[s4] = *(const f16x8*)(qip + 16 * s4); }
        float wv0[8], wv1[8];
        { const float* wp = FPTR(float, WS_WI) + (tb + t0 + 2 * half) * 8;
          const f32x4 a0 = *(const f32x4*)wp, a1 = *(const f32x4*)(wp + 4), b0 = *(const f32x4*)(wp + 8), b1 = *(const f32x4*)(wp + 12);
#pragma unroll
          for (int e = 0; e < 4; ++e) { wv0[e] = a0[e]; wv0[4 + e] = a1[e]; wv1[e] = b0[e]; wv1[4 + e] = b1[e]; } }
        asm volatile("s_waitcnt vmcnt(0)" :: "v"(Af[0]), "v"(Af[1]), "v"(Af[2]), "v"(Af[3]),
                     "v"(wv0[0]), "v"(wv0[1]), "v"(wv0[2]), "v"(wv0[3]), "v"(wv0[4]), "v"(wv0[5]), "v"(wv0[6]), "v"(wv0[7]),
                     "v"(wv1[0]), "v"(wv1[1]), "v"(wv1[2]), "v"(wv1[3]), "v"(wv1[4]), "v"(wv1[5]), "v"(wv1[6]), "v"(wv1[7]) : "memory");
        float tau0 = -__builtin_inff(), tau1 = -__builtin_inff();
        int cnt0 = 0, cnt1 = 0, cnt2 = 0, cnt3 = 0;
        const int tq0 = t0 + 2 * half, tq1 = tq0 + 1;
        for (int st = 0; st < nstage; ++st) {
            if (st > 0) asm volatile("s_waitcnt vmcnt(0)" ::: "memory");
            P3_BAR();
            {
                const int sn = (st + 1 < nstage) ? st + 1 : nstage - 1;
                __builtin_amdgcn_global_load_lds((const unsigned*)(dsrc + (size_t)sn * 128 * 64), (LAS unsigned*)(F.lds + ((st + 1) & 1) * 16384 + wid * 1024), 16, 0, 0);
                __builtin_amdgcn_global_load_lds((const unsigned*)(dsrc + (size_t)(sn * 128 + 64) * 64), (LAS unsigned*)(F.lds + ((st + 1) & 1) * 16384 + 8192 + wid * 1024), 16, 0, 0);
            }
            unsigned fl = 0u;
            if (st >= 1) fl = flg[(st - 1) % 3];
            if (st >= 2 && F.tid == 0) flg[(st - 2) % 3] = 0u;
            fl = (unsigned)__builtin_amdgcn_readfirstlane((int)fl);
            if (fl) {
                if (cnt0 > TOPK + 160) { int nc; const float tv = pack_floor(prune_fast(cb + 0 * CAP, cnt0, lane, nc)); cnt0 = nc; if (!half) tau0 = tv; }
                if (cnt1 > TOPK + 160) { int nc; const float tv = pack_floor(prune_fast(cb + 1 * CAP, cnt1, lane, nc)); cnt1 = nc; if (!half) tau1 = tv; }
                if (cnt2 > TOPK + 160) { int nc; const float tv = pack_floor(prune_fast(cb + 2 * CAP, cnt2, lane, nc)); cnt2 = nc; if (half) tau0 = tv; }
                if (cnt3 > TOPK + 160) { int nc; const float tv = pack_floor(prune_fast(cb + 3 * CAP, cnt3, lane, nc)); cnt3 = nc; if (half) tau1 = tv; }
            }
            LAS unsigned char* slot = F.lds + (st & 1) * 16384;
            const int kst0 = st * 128;
            if (kst0 <= t0 + 3) {
                f32x16 acc[4];
#pragma unroll
                for (int j = 0; j < 4; ++j) acc[j] = (f32x16){0.f, 0.f, 0.f, 0.f, 0.f, 0.f, 0.f, 0.f, 0.f, 0.f, 0.f, 0.f, 0.f, 0.f, 0.f, 0.f};
                {
                    f16x8 Bf[4][4];
#pragma unroll
                    for (int j = 0; j < 4; ++j)
#pragma unroll
                        for (int ks = 0; ks < 4; ++ks) Bf[j][ks] = *(const LAS f16x8*)(slot + j * 4096 + boff[ks]);
#pragma unroll
                    for (int ks = 0; ks < 4; ++ks)
#pragma unroll
                        for (int j = 0; j < 4; ++j) acc[j] = __builtin_amdgcn_mfma_f32_32x32x16_f16(Af[ks], Bf[j][ks], acc[j], 0, 0, 0);
                }
#pragma unroll
                for (int j = 0; j < 4; ++j) {
                    float a0 = 0.f, a1 = 0.f, b0 = 0.f, b1 = 0.f;
#pragma unroll
                    for (int h = 0; h < 8; h += 2) {
                        a0 = fmaf(wv0[h], __int_as_float(max(__float_as_int(acc[j][h]), 0)), a0);
                        a1 = fmaf(wv0[h + 1], __int_as_float(max(__float_as_int(acc[j][h + 1]), 0)), a1);
                        b0 = fmaf(wv1[h], __int_as_float(max(__float_as_int(acc[j][8 + h]), 0)), b0);
                        b1 = fmaf(wv1[h + 1], __int_as_float(max(__float_as_int(acc[j][8 + h + 1]), 0)), b1);
                    }
                    const float s0 = a0 + a1, s1 = b0 + b1;
                    const int key = kst0 + j * 32 + c31;
                    const bool h0 = (key <= tq0) && (s0 >= tau0), h1 = (key <= tq1) && (s1 >= tau1);
                    const unsigned long long m0 = __ballot(h0), m1 = __ballot(h1);
                    if (m0) {
                        const unsigned lo = (unsigned)m0, hi = (unsigned)(m0 >> 32);
                        const int pre = mbcnt64(m0) - (half ? __builtin_popcount(lo) : 0);
                        const int p = (half ? cnt2 : cnt0) + pre;
                        if (h0) cb[(2 * half) * CAP + p] = pack_cand(s0, key);
                        cnt0 += __builtin_popcount(lo); cnt2 += __builtin_popcount(hi);
                    }
                    if (m1) {
                        const unsigned lo = (unsigned)m1, hi = (unsigned)(m1 >> 32);
                        const int pre = mbcnt64(m1) - (half ? __builtin_popcount(lo) : 0);
                        const int p = (half ? cnt3 : cnt1) + pre;
                        if (h1) cb[(2 * half + 1) * CAP + p] = pack_cand(s1, key);
                        cnt1 += __builtin_popcount(lo); cnt3 += __builtin_popcount(hi);
                    }
                }
            }
            if (max(max(cnt0, cnt1), max(cnt2, cnt3)) > WMARK && lane == 0) flg[st % 3] = 1u;
        }
        asm volatile("s_waitcnt vmcnt(0)" ::: "memory");
        if (cnt0 > TOPK) { (void)select_exact(cb + 0 * CAP, cnt0, TOPK, lane); cnt0 = TOPK; }
        if (cnt1 > TOPK) { (void)select_exact(cb + 1 * CAP, cnt1, TOPK, lane); cnt1 = TOPK; }
        if (cnt2 > TOPK) { (void)select_exact(cb + 2 * CAP, cnt2, TOPK, lane); cnt2 = TOPK; }
        if (cnt3 > TOPK) { (void)select_exact(cb + 3 * CAP, cnt3, TOPK, lane); cnt3 = TOPK; }
        {
        const int hcol = lane & 15, g4 = lane >> 4;
        const unsigned vst = (unsigned)(size_t)wl + 1024u;
        const unsigned trb = vst + (unsigned)((4 * g4 + (hcol >> 2)) * 128 + 4 * (hcol & 3) * 2);
        const f16* KVb = FPTR(f16, WS_KV) + tb * 128;
        const f16* Qb = FPTR(f16, WS_Q) + (tb + t0) * 512 + hcol * 64 + 8 * g4;
        f16x8 vv[8], ka[4][2], Bq[2], Bqn[2];
#define P3_NSEL(q_) ((q_) == 0 ? cnt0 : (q_) == 1 ? cnt1 : (q_) == 2 ? cnt2 : cnt3)
#define P3_GATHER(q_, c_) do { const int ns_ = P3_NSEL(q_); LAS unsigned* iq_ = cb + (q_) * CAP; \
            unsigned wv_[12];     \
            _Pragma("unroll") for (int jj = 0; jj < 8; ++jj) wv_[jj] = iq_[(c_) * 64 + ((lane + 64 * jj) >> 3)]; \
            _Pragma("unroll") for (int k4 = 0; k4 < 4; ++k4) wv_[8 + k4] = iq_[(4 * (c_) + k4) * 16 + hcol]; \
            _Pragma("unroll") for (int jj = 0; jj < 8; ++jj) { const int p_ = lane + 64 * jj, slot_ = (c_) * 64 + (p_ >> 3); const int idx_ = slot_ < ns_ ? 8191 - (int)(wv_[jj] & 0x1FFFu) : 0; \
                vv[jj] = *(const f16x8*)(KVb + (size_t)idx_ * 128 + 64 + (p_ & 7) * 8); } \
            _Pragma("unroll") for (int k4 = 0; k4 < 4; ++k4) { const int slot_ = (4 * (c_) + k4) * 16 + hcol; const int idx_ = slot_ < ns_ ? 8191 - (int)(wv_[8 + k4] & 0x1FFFu) : 0; \
                const f16* kp_ = KVb + (size_t)idx_ * 128 + 8 * g4; ka[k4][0] = *(const f16x8*)kp_; ka[k4][1] = *(const f16x8*)(kp_ + 32); } } while (0)
#define P3_LOADQ(dst_, q_) do { _Pragma("unroll") for (int ks = 0; ks < 2; ++ks) { dst_[ks] = (f16x8){0, 0, 0, 0, 0, 0, 0, 0}; if (hcol < 8) dst_[ks] = *(const f16x8*)(Qb + (q_) * 512 + 32 * ks); } } while (0)
        int q = 0, c = 0;
        P3_GATHER(0, 0); P3_LOADQ(Bq, 0);
        f32x4 O[4];
#pragma unroll
        for (int mt = 0; mt < 4; ++mt) O[mt] = (f32x4){0.f, 0.f, 0.f, 0.f};
        float mrun = -__builtin_inff(), lrun = 0.f;
#pragma unroll 1
        for (;;) {
            const int nsel = P3_NSEL(q);
#pragma unroll
            for (int jj = 0; jj < 8; ++jj) { const int p = lane + 64 * jj, kk = p >> 3; *(LAS f16x8*)(wl + (kk >> 4) * P3_QB + 1024 + (kk & 15) * 128 + (p & 7) * 16) = vv[jj]; }
            float lg[4][4];
#pragma unroll
            for (int k4 = 0; k4 < 4; ++k4) {
                f32x4 d = {0.f, 0.f, 0.f, 0.f};
                d = __builtin_amdgcn_mfma_f32_16x16x32_f16(ka[k4][0], Bq[0], d, 0, 0, 0);
                d = __builtin_amdgcn_mfma_f32_16x16x32_f16(ka[k4][1], Bq[1], d, 0, 0, 0);
#pragma unroll
                for (int r = 0; r < 4; ++r) lg[k4][r] = ((4 * c + k4) * 16 + 4 * g4 + r < nsel) ? d[r] : -__builtin_inff();
            }
            const bool lastc = (c + 1) * 64 >= nsel;
            const int qn = lastc ? q + 1 : q, cn = lastc ? 0 : c + 1;
            const bool has_next = qn < 4;
            if (has_next) { P3_GATHER(qn, cn); if (lastc) P3_LOADQ(Bqn, qn); }
            float cm = -__builtin_inff();
#pragma unroll
            for (int k4 = 0; k4 < 4; ++k4)
#pragma unroll
                for (int r = 0; r < 4; ++r) cm = fmaxf(cm, lg[k4][r]);
            { const auto pr = __builtin_amdgcn_permlane32_swap(__float_as_uint(cm), __float_as_uint(cm), false, false); cm = fmaxf(__uint_as_float(pr[0]), __uint_as_float(pr[1])); }
            cm = fmaxf(cm, __shfl_xor(cm, 16));
            const float mnew = fmaxf(mrun, cm);
            const float alpha = __expf(mrun - mnew);
            mrun = mnew; lrun *= alpha;
#pragma unroll
            for (int mt = 0; mt < 4; ++mt) O[mt] *= alpha;
#pragma unroll
            for (int k4 = 0; k4 < 4; ++k4)
#pragma unroll
                for (int r = 0; r < 4; ++r) { const float e = __expf(lg[k4][r] - mnew); lg[k4][r] = e; lrun += e; }
#pragma unroll
            for (int k2 = 0; k2 < 2; ++k2) {
                f16x8 Bp;
#pragma unroll
                for (int r = 0; r < 4; ++r) { Bp[r] = (f16)lg[2 * k2][r]; Bp[4 + r] = (f16)lg[2 * k2 + 1][r]; }
                f16x4 tv[8];
                tr_read8(trb + (unsigned)(k2 * 2 * P3_QB), tv);
#pragma unroll
                for (int mt = 0; mt < 4; ++mt) {
                    const f16x4 v0 = tv[2 * mt], v1 = tv[2 * mt + 1];
                    const f16x8 Av = {v0[0], v0[1], v0[2], v0[3], v1[0], v1[1], v1[2], v1[3]};
                    O[mt] = __builtin_amdgcn_mfma_f32_16x16x32_f16(Av, Bp, O[mt], 0, 0, 0);
                }
            }
            if (lastc) {
                { const auto pr = __builtin_amdgcn_permlane32_swap(__float_as_uint(lrun), __float_as_uint(lrun), false, false); lrun = __uint_as_float(pr[0]) + __uint_as_float(pr[1]); }
                lrun += __shfl_xor(lrun, 16);
                const float inv = 1.f / lrun;
                if (hcol < 8) {
#pragma unroll
                    for (int mt = 0; mt < 4; ++mt) { f16x4 o;
_Pragma("unroll") for (int r = 0; r < 4; ++r) o[r] = (f16)(O[mt][r] * inv);
                        *(f16x4*)(FPTR(f16, WS_AO) + (tb + t0 + q) * DM + hcol * 64 + 16 * mt + 4 * g4) = o; }
                }
#pragma unroll
                for (int mt = 0; mt < 4; ++mt) O[mt] = (f32x4){0.f, 0.f, 0.f, 0.f};
                mrun = -__builtin_inff(); lrun = 0.f;
                Bq[0] = Bqn[0]; Bq[1] = Bqn[1];
            }
            if (!has_next) break;
            q = qn; c = cn;
        }
#undef P3_NSEL
#undef P3_GATHER
#undef P3_LOADQ
        }
        ucode = __builtin_amdgcn_readfirstlane((int)flg[4]);
    }
}

struct EpiOut {
    const float* x; f16* x1h; const float* MOD;
    __device__ __forceinline__ void operator()(const f32x4 (&acc)[2][2][4][2], const gm::DenseSched::Unit& u, int wr, int wc, int fr, int fq) const {
        asm volatile("" : "+v"(fr), "+v"(fq));
        const int b = (u.pm * 256) / SEQ;
        f32x4 gt[2][2];
#pragma unroll
        for (int bj = 0; bj < 2; ++bj)
#pragma unroll
            for (int n = 0; n < 2; ++n) gt[bj][n] = *(const f32x4*)(MOD + (size_t)b * 6144 + 2048 + u.pn * 256 + bj * 128 + wc * 32 + fq * 8 + n * 4);
#pragma unroll
        for (int ai = 0; ai < 2; ++ai) {
            f32x4 xv[4][2][2];
#pragma unroll
            for (int m = 0; m < 4; ++m) {
                const size_t t = (size_t)u.pm * 256 + ai * 128 + wr * 64 + m * 16 + fr;
#pragma unroll
                for (int bj = 0; bj < 2; ++bj) { const size_t o = t * DM + u.pn * 256 + bj * 128 + wc * 32 + fq * 8; xv[m][bj][0] = *(const f32x4*)(x + o); xv[m][bj][1] = *(const f32x4*)(x + o + 4); }
            }
#pragma unroll
            for (int m = 0; m < 4; ++m) {
                const size_t t = (size_t)u.pm * 256 + ai * 128 + wr * 64 + m * 16 + fr;
#pragma unroll
                for (int bj = 0; bj < 2; ++bj) { const size_t o = t * DM + u.pn * 256 + bj * 128 + wc * 32 + fq * 8;
                    const f32x4 r0 = xv[m][bj][0] + gt[bj][0] * acc[ai][bj][m][0], r1 = xv[m][bj][1] + gt[bj][1] * acc[ai][bj][m][1]; f16x8 h;
_Pragma("unroll") for (int e = 0; e < 4; ++e) { h[e] = (f16)r0[e]; h[4 + e] = (f16)r1[e]; }
                    *(f16x8*)(x1h + o) = h; }
            }
        }
    }
};

__device__ __forceinline__ void p5_norm_route(const Frame& F, const Args& a) {
    LAS float* gs = (LAS float*)F.lds; LAS float* sh = gs + 1024;
    LAS float* cvec = sh + 1024;
    LAS float* lgl = cvec + 64;
    LAS int* sel_e = (LAS int*)(lgl + 8 * 16 * 40);
    LAS float* sel_c = (LAS float*)(sel_e + 256);
    LAS int* sel_p = (LAS int*)(sel_c + 256);
    LAS int* cntL = sel_p + 256;
    LAS int* baseL = cntL + 32;
    LAS int* ccntL = (LAS int*)(F.lds + 135168);
    LAS int* cbaseL = ccntL + 128;
    LAS int* sel_cls = cbaseL + 128;
    LAS int* sel_cp = sel_cls + 128;
    const f16* x1 = FPTR(f16, WS_X1H);
    const float* WRT = FPTR(float, WS_WRT);
    const int lane = F.lane, r16 = lane & 15, g4 = lane >> 4;
    int curb = -1;
    for (int rb = blockIdx.x; rb < NT / 128; rb += F.G) {
        const int b = (rb * 128) / SEQ;
        __syncthreads();
        if (b != curb) {
            for (int cidx = F.tid; cidx < 1024; cidx += 512) { sh[cidx] = FPTR(float, WS_MOD)[(size_t)b * 6144 + 3072 + cidx]; gs[cidx] = a.g_ffn[cidx] * (1.f + FPTR(float, WS_MOD)[(size_t)b * 6144 + 4096 + cidx]); }
            __syncthreads();
            for (int o = F.wave; o < 36; o += 8) {
                float sacc = 0.f;
#pragma unroll
                for (int j = 0; j < 4; ++j) { const f32x4 w = *(const f32x4*)(WRT + (size_t)o * 1024 + 256 * j + 4 * lane);
#pragma unroll
                    for (int e = 0; e < 4; ++e) sacc += sh[256 * j + 4 * lane + e] * w[e]; }
                sacc = wave_sum(sacc);
                if (lane == 0) cvec[o] = sacc + (o < 4 ? a.b_rg[o] : a.b_re[o - 4]);
            }
            curb = b;
        }
        if (F.tid < 32) cntL[F.tid] = 0;
        if (F.tid < 128) ccntL[F.tid] = 0;
        __syncthreads();
        const size_t row0 = (size_t)rb * 128 + F.wave * 16;
        const f16* xp = x1 + (row0 + r16) * DM + 8 * g4;
        f32x4 accA[3], accB[3];
#pragma unroll
        for (int nt = 0; nt < 3; ++nt) { accA[nt] = (f32x4){0.f, 0.f, 0.f, 0.f}; accB[nt] = accA[nt]; }
        float ss = 0.f;
        LAS f16* Wsh = (LAS f16*)(F.lds + 32768); LAS f16* Wsl = Wsh + 48 * 520;
#pragma unroll 1
        for (int kh = 0; kh < 2; ++kh) {
            __syncthreads();
            for (int c = F.tid; c < 48 * 64; c += 512) {
                const int o = c >> 6, k8 = (c & 63) * 8;
                *(LAS f16x8*)(Wsh + o * 520 + k8) = *(const f16x8*)(FPTR(f16, WS_WRH) + (size_t)o * 1024 + kh * 512 + k8);
                *(LAS f16x8*)(Wsl + o * 520 + k8) = *(const f16x8*)(FPTR(f16, WS_WRL) + (size_t)o * 1024 + kh * 512 + k8);
            }
            __syncthreads();
#pragma unroll 2
            for (int k2 = 0; k2 < 16; ++k2) {
                const int ks = kh * 16 + k2;
                const f16x8 xh = *(const f16x8*)(xp + 32 * ks);
                const f32x4 g0 = *(const LAS f32x4*)(gs + 32 * ks + 8 * g4), g1 = *(const LAS f32x4*)(gs + 32 * ks + 8 * g4 + 4);
                f16x8 bh[3], bl[3];
#pragma unroll
                for (int nt = 0; nt < 3; ++nt) { bh[nt] = *(const LAS f16x8*)(Wsh + (nt * 16 + r16) * 520 + 32 * k2 + 8 * g4); bl[nt] = *(const LAS f16x8*)(Wsl + (nt * 16 + r16) * 520 + 32 * k2 + 8 * g4); }
                f16x8 ahi, alo;
#pragma unroll
                for (int j = 0; j < 8; ++j) {
                    const float xv = (float)xh[j]; ss += xv * xv;
                    const float av = xv * (j < 4 ? g0[j] : g1[j - 4]);
                    ahi[j] = (f16)av; alo[j] = (f16)((av - (float)ahi[j]) * 2048.f);
                }
#pragma unroll
                for (int nt = 0; nt < 3; ++nt) {
                    accA[nt] = __builtin_amdgcn_mfma_f32_16x16x32_f16(ahi, bh[nt], accA[nt], 0, 0, 0);
                    accB[nt] = __builtin_amdgcn_mfma_f32_16x16x32_f16(alo, bh[nt], accB[nt], 0, 0, 0);
                    accB[nt] = __builtin_amdgcn_mfma_f32_16x16x32_f16(ahi, bl[nt], accB[nt], 0, 0, 0);
                }
            }
        }
        f32x4 acc[3];
#pragma unroll
        for (int nt = 0; nt < 3; ++nt) acc[nt] = accA[nt] + accB[nt] * (1.f / 2048.f);
        ss += __shfl_xor(ss, 16); ss += __shfl_xor(ss, 32);
        const float rstd = rsqrtf(ss * (1.f / 1024.f) + EPSN);
#pragma unroll
        for (int e = 0; e < 4; ++e) {
            const float rs = __shfl(rstd, 4 * g4 + e);
#pragma unroll
            for (int nt = 0; nt < 3; ++nt) { const int o = nt * 16 + r16; if (o < 36) lgl[(F.wave * 16 + 4 * g4 + e) * 40 + o] = rs * acc[nt][e] + cvec[o]; }
        }
        if (lane < 16) {
            float L[36];
#pragma unroll
            for (int o = 0; o < 36; ++o) L[o] = lgl[(F.wave * 16 + lane) * 40 + o];
            int gsel = 0; float gmax = -__builtin_inff();
#pragma unroll
            for (int g = 0; g < 4; ++g) if (L[g] > gmax) { gmax = L[g]; gsel = g; }
            float gden = 0.f;
#pragma unroll
            for (int g = 0; g < 4; ++g) gden += __expf(L[g] - gmax);
            const float pg = 1.f / gden;
            float el[8];
#pragma unroll
            for (int e = 0; e < 8; ++e) {
                float v = 0.f;
#pragma unroll
                for (int g = 0; g < 4; ++g) v = (gsel == g) ? L[4 + g * 8 + e] : v;
                el[e] = v;
            }
            int e1 = 0; float m1 = -__builtin_inff();
#pragma unroll
            for (int e = 0; e < 8; ++e) if (el[e] > m1) { m1 = el[e]; e1 = e; }
            int e2 = 0; float m2 = -__builtin_inff();
#pragma unroll
            for (int e = 0; e < 8; ++e) if (e != e1 && el[e] > m2) { m2 = el[e]; e2 = e; }
            const float p2 = __expf(m2 - m1), den = 1.f + p2;
            const int tl = F.wave * 16 + lane;
            sel_e[tl * 2] = gsel * 8 + e1; sel_e[tl * 2 + 1] = gsel * 8 + e2;
            sel_c[tl * 2] = pg / den; sel_c[tl * 2 + 1] = pg * p2 / den;
            { const int ea = e1 < e2 ? e1 : e2, eb = e1 < e2 ? e2 : e1;
              sel_cls[tl] = (gsel * 28 + (ea * (15 - ea)) / 2 + (eb - ea - 1)) | ((e1 < e2 ? 0 : 1) << 8); }
        }
#pragma unroll 1
        for (int rq = 0; rq < 4; ++rq) {
            f32x4 v[4][4];
#pragma unroll
            for (int r = 0; r < 4; ++r)
#pragma unroll
                for (int j = 0; j < 4; ++j) { const f16x4 xh = *(const f16x4*)(x1 + (row0 + rq * 4 + r) * DM + 256 * j + 4 * lane); v[r][j] = (f32x4){(float)xh[0], (float)xh[1], (float)xh[2], (float)xh[3]}; }
#pragma unroll
            for (int r = 0; r < 4; ++r) {
                const float rs = __int_as_float(__builtin_amdgcn_readlane(__float_as_int(rstd), rq * 4 + r));
                const size_t t = row0 + rq * 4 + r;
#pragma unroll
                for (int j = 0; j < 4; ++j) {
                    const int c0 = 256 * j + 4 * lane; f16x4 o;
#pragma unroll
                    for (int e = 0; e < 4; ++e) o[e] = (f16)(v[r][j][e] * rs * gs[c0 + e] + sh[c0 + e]);
                    *(f16x4*)(FPTR(f16, WS_H) + t * DM + c0) = o;
                }
            }
        }
        __syncthreads();
        if (F.tid < 256) sel_p[F.tid] = __hip_atomic_fetch_add(&cntL[sel_e[F.tid]], 1, __ATOMIC_RELAXED, __HIP_MEMORY_SCOPE_WORKGROUP);
        if (F.tid >= 256 && F.tid < 384) sel_cp[F.tid - 256] = __hip_atomic_fetch_add(&ccntL[sel_cls[F.tid - 256] & 255], 1, __ATOMIC_RELAXED, __HIP_MEMORY_SCOPE_WORKGROUP);
        __syncthreads();
        if (F.tid < 32) baseL[F.tid] = (int)atomicAdd(FPTR(unsigned, WS_CTL) + CW_CNT + F.tid, (unsigned)cntL[F.tid]);
        if (F.tid >= 64 && F.tid < 64 + NCLS) cbaseL[F.tid - 64] = (int)atomicAdd(FPTR(unsigned, WS_CTL) + CW_CCNT + (F.tid - 64), (unsigned)ccntL[F.tid - 64]);
        __syncthreads();
        if (F.tid < 256) {
            const int e = sel_e[F.tid], p = baseL[e] + sel_p[F.tid];
            const int t = rb * 128 + (F.tid >> 1);
            FPTR(int, WS_LISTT)[(size_t)e * NT + p] = t; FPTR(float, WS_LISTC)[(size_t)e * NT + p] = sel_c[F.tid];
            FPTR(unsigned, WS_TOKROW)[(size_t)t * 2 + (F.tid & 1)] = ((unsigned)e << 20) | (unsigned)p;
            { const int tk = F.tid >> 1, sc = sel_cls[tk], cls = sc & 255, h0 = sc >> 8, hh = (F.tid & 1) ? 1 - h0 : h0;
              FPTR(unsigned, WS_LISTD)[(size_t)e * NT + p] = ((unsigned)cls << 17) | ((unsigned)(cbaseL[cls] + sel_cp[tk]) << 1) | (unsigned)hh; }
        }
    }
}

struct MoeTables { LAS int* pre; LAS int* cnt; LAS unsigned char* tmap; LAS int* cpre; LAS int* ccnt; LAS int* cpair; LAS unsigned char* ctmap; };
__device__ __forceinline__ void moe_tables_build(const Frame& F, MoeTables& mt) {
    mt.pre = (LAS int*)(F.lds + LDS_MISC + 256); mt.cnt = mt.pre + 40; mt.tmap = (LAS unsigned char*)(mt.pre + 80);
    __syncthreads();
    if (F.tid < 32) mt.cnt[F.tid] = (int)__hip_atomic_load(FPTR(unsigned, WS_CTL) + CW_CNT + F.tid, __ATOMIC_RELAXED, __HIP_MEMORY_SCOPE_AGENT);
    __syncthreads();
    if (F.tid == 0) {
        int acc = 0;
        for (int e = 0; e < NEXP; ++e) { mt.pre[e] = acc; acc += (mt.cnt[e] + 255) >> 8; }
        mt.pre[NEXP] = acc;
    }
    __syncthreads();
    mt.cpre = (LAS int*)(F.lds + 131072); mt.ccnt = mt.cpre + 128; mt.cpair = mt.ccnt + 128; mt.ctmap = (LAS unsigned char*)(mt.cpair + 128);
    if (F.tid < NCLS) {
        mt.ccnt[F.tid] = (int)__hip_atomic_load(FPTR(unsigned, WS_CTL) + CW_CCNT + F.tid, __ATOMIC_RELAXED, __HIP_MEMORY_SCOPE_AGENT);
        const int g = F.tid / 28; int a = 0, rem = F.tid - g * 28;
        while (rem >= 7 - a) { rem -= 7 - a; ++a; }
        mt.cpair[F.tid] = (g * 8 + a) | ((g * 8 + a + 1 + rem) << 8);
    }
    __syncthreads();
    if (F.tid == 0) {
        int acc = 0;
        for (int c = 0; c < NCLS; ++c) { mt.cpre[c] = acc; acc += (mt.ccnt[c] + 255) >> 8; }
        mt.cpre[NCLS] = acc;
    }
    __syncthreads();
    for (int tl = F.tid; tl < mt.cpre[NCLS]; tl += 512) {
        int c = 0;
        for (int k = 1; k < NCLS; ++k) c = (tl >= mt.cpre[k]) ? k : c;
        mt.ctmap[tl] = (unsigned char)c;
    }
    for (int tl = F.tid; tl < mt.pre[NEXP]; tl += 512) {
        int e = 0;
        for (int k = 1; k < NEXP; ++k) e = (tl >= mt.pre[k]) ? k : e;
        mt.tmap[tl] = (unsigned char)e;
    }
    __syncthreads();
}
template <int NPN, int KDIM, bool GATHER_>
struct MoeSched {
    static constexpr bool GATHER = GATHER_;
    struct Unit { int e, mt, pn, cnt; };
    MoeTables T; int G, c; const int* listt; const char* Bt; size_t bexp;
    __device__ __forceinline__ bool next(int i, Unit& u) const {
        const int L0 = i * G + c, total = T.pre[NEXP], nwg = total * NPN;
        if (L0 >= nwg) return false;
        int L; { const int q = nwg / 8, r = nwg % 8, xcd = L0 % 8, off = L0 / 8; L = (xcd < r ? xcd * (q + 1) : r * (q + 1) + (xcd - r) * q) + off; }
        const int tl = L / NPN; u.pn = L - tl * NPN;
        u.e = __builtin_amdgcn_readfirstlane((int)T.tmap[tl]); u.mt = tl - T.pre[u.e]; u.cnt = T.cnt[u.e]; u.cnt = __builtin_amdgcn_readfirstlane(u.cnt); u.mt = __builtin_amdgcn_readfirstlane(u.mt);
        return true;
    }
    __device__ __forceinline__ unsigned arow(const Unit& u, int r) const {
        const int li = u.mt * 256 + r;
        if (GATHER) return (unsigned)listt[(size_t)u.e * NT + (li < u.cnt ? li : 0)];
        return (unsigned)(T.pre[u.e] * 256 + li);
    }
    __device__ __forceinline__ size_t abase(const Unit& u) const { return (size_t)(T.pre[u.e] * 256 + u.mt * 256) * KDIM * 2; }
    struct BP { const char* p; };
    __device__ __forceinline__ BP bbase(const Unit& u) const { return BP{Bt + (size_t)u.e * bexp + (size_t)u.pn * 256 * KDIM * 2}; }
    __device__ __forceinline__ const char* bat(const BP& b, int t) const { return b.p + (size_t)t * 128; }
};
typedef MoeSched<2, 1024, true> MoeSched1;
typedef MoeSched<4, 256, false> MoeSched2;

struct MoeSched3 {
    static constexpr bool GATHER = false;
    struct Unit { int cls, mt, pn, cnt, ea, eb; };
    struct BP { const char* p0; const char* p1; };
    MoeTables T; int G, c; const char* Bt;
    __device__ __forceinline__ bool next(int i, Unit& u) const {
        const int L0 = i * G + c, total = T.cpre[NCLS], nwg = total * 4;
        if (L0 >= nwg) return false;
        int L; { const int q = nwg / 8, r = nwg % 8, xcd = L0 % 8, off = L0 / 8; L = (xcd < r ? xcd * (q + 1) : r * (q + 1) + (xcd - r) * q) + off; }
        const int tl = L >> 2; u.pn = L & 3;
        const int cls = __builtin_amdgcn_readfirstlane((int)T.ctmap[tl]);
        u.cls = cls; u.mt = __builtin_amdgcn_readfirstlane(tl - T.cpre[cls]); u.cnt = __builtin_amdgcn_readfirstlane(T.ccnt[cls]);
        const int pr = __builtin_amdgcn_readfirstlane(T.cpair[cls]); u.ea = pr & 255; u.eb = pr >> 8;
        return true;
    }
    __device__ __forceinline__ unsigned arow(const Unit&, int) const { return 0u; }
    __device__ __forceinline__ size_t abase(const Unit& u) const { return (size_t)(T.cpre[u.cls] + u.mt) * 256 * 512 * 2; }
    __device__ __forceinline__ BP bbase(const Unit& u) const { const size_t po = (size_t)u.pn * 256 * DEXP * 2; return BP{Bt + (size_t)u.ea * DM * DEXP * 2 + po, Bt + (size_t)u.eb * DM * DEXP * 2 + po}; }
    __device__ __forceinline__ const char* bat(const BP& b, int t) const { return (t < 4 ? b.p0 : b.p1) + (size_t)(t & 3) * 128; }
};

struct EpiFinal {
    const f16* x1h; float* out; const int* tokr; MoeTables T; LAS float* gl;
    __device__ __forceinline__ void operator()(const f32x4 (&acc)[2][2][4][2], const MoeSched3::Unit& u, int wr, int wc, int fr, int fq) const {
        asm volatile("" : "+v"(fr), "+v"(fq));
        const size_t rbase = (size_t)(T.cpre[u.cls] + u.mt) * 256;
        int tok[2][4];
#pragma unroll
        for (int ai = 0; ai < 2; ++ai)
#pragma unroll
            for (int m = 0; m < 4; ++m) {
                const int lr = ai * 128 + wr * 64 + m * 16 + fr;
                const int tv = tokr[rbase + lr];
                tok[ai][m] = (u.mt * 256 + lr < u.cnt) ? tv : -1;
            }
#pragma unroll
        for (int ai = 0; ai < 2; ++ai) {
            f16x8 xv[4][2];
#pragma unroll
            for (int m = 0; m < 4; ++m) { const size_t tt = (size_t)(tok[ai][m] < 0 ? 0 : tok[ai][m]);
#pragma unroll
                for (int bj = 0; bj < 2; ++bj) xv[m][bj] = *(const f16x8*)(x1h + tt * DM + u.pn * 256 + bj * 128 + wc * 32 + fq * 8); }
#pragma unroll
            for (int m = 0; m < 4; ++m) {
                const int tv = tok[ai][m]; const size_t tt = (size_t)(tv < 0 ? 0 : tv);
                const int b = (int)(tt >> 13);
#pragma unroll
                for (int bj = 0; bj < 2; ++bj) { const int col = u.pn * 256 + bj * 128 + wc * 32 + fq * 8;
                    const f32x4 g0 = *(const LAS f32x4*)(gl + b * 1024 + col), g1 = *(const LAS f32x4*)(gl + b * 1024 + col + 4);
                    f32x4 o0, o1;
_Pragma("unroll") for (int e = 0; e < 4; ++e) { o0[e] = (float)xv[m][bj][e] + g0[e] * acc[ai][bj][m][0][e]; o1[e] = (float)xv[m][bj][4 + e] + g1[e] * acc[ai][bj][m][1][e]; }
                    if (tv >= 0) { *(f32x4*)(out + tt * DM + col) = o0; *(f32x4*)(out + tt * DM + col + 4) = o1; } }
            }
        }
    }
};

struct EpiSwiglu {
    f16* ACT; MoeTables T; f16* ACT2; const unsigned* listd; const float* listc; const int* listt; int* tokr;
    __device__ __forceinline__ void operator()(const f32x4 (&acc)[2][2][4][2], const MoeSched1::Unit& u, int wr, int wc, int fr, int fq) const {
        asm volatile("" : "+v"(fr), "+v"(fq));
        unsigned dd[2][4]; float cw[2][4]; int tk[2][4];
        const bool tw = (u.pn == 0) && (wc == 0) && (fq == 0);
#pragma unroll
        for (int ai = 0; ai < 2; ++ai)
#pragma unroll
            for (int m = 0; m < 4; ++m) {
                const int li = u.mt * 256 + ai * 128 + wr * 64 + m * 16 + fr; const size_t lo = (size_t)u.e * NT + (li < u.cnt ? li : 0);
                dd[ai][m] = listd[lo]; cw[ai][m] = listc[lo]; tk[ai][m] = 0;
                if (tw) tk[ai][m] = listt[lo];
            }
#pragma unroll
        for (int ai = 0; ai < 2; ++ai)
#pragma unroll
            for (int m = 0; m < 4; ++m) {
                const int li = u.mt * 256 + ai * 128 + wr * 64 + m * 16 + fr;
                const unsigned d = dd[ai][m];
                const size_t row2 = (size_t)T.cpre[d >> 17] * 256 + ((d >> 1) & 0xFFFFu);
                f16x8 o2;
#pragma unroll
                for (int n = 0; n < 2; ++n)
#pragma unroll
                    for (int e = 0; e < 4; ++e) o2[n * 4 + e] = (f16)(silu_f(acc[ai][0][m][n][e]) * acc[ai][1][m][n][e] * cw[ai][m]);
                if (li < u.cnt) {
                    *(f16x8*)(ACT2 + row2 * 512 + (d & 1u) * 256 + u.pn * 128 + wc * 32 + fq * 8) = o2;
                    if (tw && (d & 1u) == 0u) tokr[row2] = tk[ai][m];
                }
            }
    }
};
struct EpiY {
    f16* Y; const float* listc; MoeTables T;
    __device__ __forceinline__ void operator()(const f32x4 (&acc)[2][2][4][2], const MoeSched2::Unit& u, int wr, int wc, int fr, int fq) const {
        const size_t rbase = (size_t)T.pre[u.e] * 256 + (size_t)u.mt * 256;
        asm volatile("" : "+v"(fr), "+v"(fq));
        float cw[2][4];
#pragma unroll
        for (int ai = 0; ai < 2; ++ai)
#pragma unroll
            for (int m = 0; m < 4; ++m) {
                const int li = u.mt * 256 + ai * 128 + wr * 64 + m * 16 + fr;
                cw[ai][m] = listc[(size_t)u.e * NT + (li < u.cnt ? li : 0)];
                cw[ai][m] = li < u.cnt ? cw[ai][m] : 0.f;
            }
#pragma unroll
        for (int ai = 0; ai < 2; ++ai)
#pragma unroll
            for (int m = 0; m < 4; ++m) {
                const size_t row = rbase + ai * 128 + wr * 64 + m * 16 + fr;
#pragma unroll
                for (int bj = 0; bj < 2; ++bj) { f16x8 o;
#pragma unroll
                    for (int n = 0; n < 2; ++n)
#pragma unroll
                        for (int e = 0; e < 4; ++e) o[n * 4 + e] = (f16)(cw[ai][m] * acc[ai][bj][m][n][e]);
                    *(f16x8*)(Y + row * DM + u.pn * 256 + bj * 128 + wc * 32 + fq * 8) = o; }
            }
    }
};

__device__ __forceinline__ void p8_combine(const Frame& F, const Args& a, const MoeTables& T) {
    for (int task = blockIdx.x * 512 + F.tid; task < NT * 128; task += F.G * 512) {
        const int t = task >> 7, c8 = (task & 127) * 8, b = t / SEQ;
        const unsigned r0 = FPTR(unsigned, WS_TOKROW)[(size_t)t * 2], r1 = FPTR(unsigned, WS_TOKROW)[(size_t)t * 2 + 1];
        const size_t row0 = (size_t)T.pre[r0 >> 20] * 256 + (r0 & 0xFFFFFu), row1 = (size_t)T.pre[r1 >> 20] * 256 + (r1 & 0xFFFFFu);
        const f16x8 y0 = *(const f16x8*)(FPTR(f16, WS_Y) + row0 * DM + c8), y1 = *(const f16x8*)(FPTR(f16, WS_Y) + row1 * DM + c8);
        const float* gp = FPTR(float, WS_MOD) + (size_t)b * 6144 + 5120 + c8;
        const f32x4 g0 = *(const f32x4*)gp, g1 = *(const f32x4*)(gp + 4);
        float* op = a.out + (size_t)t * DM + c8;
        const f16x8 xh = *(const f16x8*)(FPTR(f16, WS_X1H) + (size_t)t * DM + c8);
        f32x4 o0, o1;
#pragma unroll
        for (int e = 0; e < 4; ++e) { o0[e] = (float)xh[e] + g0[e] * ((float)y0[e] + (float)y1[e]); o1[e] = (float)xh[4 + e] + g1[e] * ((float)y0[4 + e] + (float)y1[4 + e]); }
        *(f32x4*)op = o0; *(f32x4*)(op + 4) = o1;
    }
}

__global__ void __launch_bounds__(512, 2) fwd(Args args) {
    extern __shared__ __attribute__((aligned(16))) unsigned char lds_raw[];
    Frame F;
    F.lds = (LAS unsigned char*)lds_raw;
    F.tid = threadIdx.x; F.lane = F.tid & 63; F.wave = __builtin_amdgcn_readfirstlane(F.tid >> 6); F.G = gridDim.x;
    F.ws = args.ws;
    volatile LAS unsigned* misc = (volatile LAS unsigned*)(F.lds + LDS_MISC);
    if (F.tid < 64) misc[F.tid] = 0u;
    __syncthreads();
    const int lo = args.ph_lo, hi = args.ph_hi;
    const bool fused = (hi - lo) > 1;
    XcdBarrier bar; bar.bar = (unsigned*)(FPTR(unsigned, WS_CTL) + CW_BAR); bar.x = 0; bar.st = misc;
    if (fused) bar = xcd_barrier_post((unsigned*)(FPTR(unsigned, WS_CTL) + CW_BAR), misc);
#ifndef PH_MASK
#define PH_MASK 0x1FF
#endif
#define IN(k) (((PH_MASK >> (k)) & 1) && lo <= (k) && (k) < hi)
#define SEAM(k) do { if (IN(k) && IN((k) + 1)) xcd_barrier(bar); } while (0)

    if (IN(0)) { for (int rep = 0; rep < NREP(0); ++rep) p0_prologue(F, args); } SEAM(0);
    if (IN(1)) { for (int rep = 0; rep < NREP(1); ++rep) p1_norm(F, args); } SEAM(1);
    if (IN(2)) {
        gm::DenseSched S; S.init(NT, NIN, DM, F.G, (int)blockIdx.x, FPTR(f16, WS_BTIN));
        EpiIn E{args.ws};
        for (int rep = 0; rep < NREP(2); ++rep) gm::gemm_phase<EpiIn, gm::DenseSched, true>(F.lds, (const char*)FPTR(f16, WS_H), DM, DM, S, E);
    } SEAM(2);
    if (IN(3)) {
        p3_dsa(F);
        for (;;) {
            __syncthreads();
            if (F.tid == 0) misc[24] = atomicAdd(FPTR(unsigned, WS_CTL) + CW_P3Q + 256, 1u);
            __syncthreads();
            const int chunk = (int)misc[24];
            if (chunk >= (NT / 16) * 64 / 512) break;
            p3_pool(F, chunk);
        }
    } SEAM(3);
    if (IN(4)) {
        gm::DenseSched S; S.init(NT, DM, DM, F.G, (int)blockIdx.x, FPTR(f16, WS_BTOUT));
        EpiOut E{args.x, FPTR(f16, WS_X1H), FPTR(float, WS_MOD)};
        for (int rep = 0; rep < NREP(4); ++rep) gm::gemm_phase<EpiOut, gm::DenseSched, true>(F.lds, (const char*)FPTR(f16, WS_AO), DM, DM, S, E);
    } SEAM(4);
    if (IN(5)) { p5_norm_route(F, args); } SEAM(5);
    MoeTables MT; MT.pre = nullptr; MT.cnt = nullptr; MT.tmap = nullptr; MT.cpre = nullptr; MT.ccnt = nullptr; MT.cpair = nullptr; MT.ctmap = nullptr;
    if (IN(6) || IN(7)) moe_tables_build(F, MT);
    if (IN(6)) {
        MoeSched1 S; S.T = MT; S.G = F.G; S.c = (int)blockIdx.x; S.listt = FPTR(int, WS_LISTT); S.Bt = (const char*)FPTR(f16, WS_BT1); S.bexp = (size_t)512 * DM * 2;
        EpiSwiglu E{FPTR(f16, WS_ACT), MT, FPTR(f16, WS_ACT2), FPTR(unsigned, WS_LISTD), FPTR(float, WS_LISTC), FPTR(int, WS_LISTT), FPTR(int, WS_TOKR)};
        for (int rep = 0; rep < NREP(6); ++rep) gm::gemm_phase<EpiSwiglu, MoeSched1, true>(F.lds, (const char*)FPTR(f16, WS_H), DM, DM, S, E);
    } SEAM(6);
    if (IN(7)) {
        LAS float* gl = (LAS float*)(F.lds + 131072 + 4096);
        for (int i = F.tid; i < 4096; i += 512) gl[i] = FPTR(float, WS_MOD)[(size_t)(i >> 10) * 6144 + 5120 + (i & 1023)];
        __syncthreads();
        MoeSched3 S; S.T = MT; S.G = F.G; S.c = (int)blockIdx.x; S.Bt = (const char*)FPTR(f16, WS_BT2);
        EpiFinal E{FPTR(f16, WS_X1H), args.out, FPTR(int, WS_TOKR), MT, gl};
        gm::gemm_phase<EpiFinal, MoeSched3, true>(F.lds, (const char*)FPTR(f16, WS_ACT2), 512, DEXP, S, E);
    }
#undef IN
#undef SEAM
}

extern "C" void kernel_launch(void* const* d_in, const int* in_sizes, int n_in, void* d_out, int out_size, void* d_ws, size_t ws_size, hipStream_t stream) {
    static int grid = 0;
    if (grid == 0) {
        if (n_in != 21 || out_size != NT * DM || ws_size < WS_END) { fprintf(stderr, "kernel_launch: unexpected problem (n_in %d, out %d, ws %zu < %zu)\n", n_in, out_size, ws_size, (size_t)WS_END); grid = -1; return; }
        int dev = 0, cus = 0, per_cu = 0;
        if (hipGetDevice(&dev) != hipSuccess || hipDeviceGetAttribute(&cus, hipDeviceAttributeMultiprocessorCount, dev) != hipSuccess) { grid = -1; return; }
        if (hipFuncSetAttribute((const void*)fwd, hipFuncAttributeMaxDynamicSharedMemorySize, LDS_BYTES) != hipSuccess) { fprintf(stderr, "kernel_launch: hipFuncSetAttribute failed\n"); grid = -1; return; }
        if (hipOccupancyMaxActiveBlocksPerMultiprocessor(&per_cu, (const void*)fwd, 512, LDS_BYTES) != hipSuccess || per_cu < 1) { fprintf(stderr, "kernel_launch: occupancy query says %d\n", per_cu); }
        (void)hipGetLastError();
        grid = cus & ~3;
        if (grid < 4) grid = 4;
    }
    if (grid < 0) return;
    (void)hipMemsetAsync((char*)d_ws + WS_CTL, 0, CTL_BYTES, stream);
    Args a{};
    a.x = (const float*)d_in[0]; a.c = (const float*)d_in[1]; a.pos = (const int*)d_in[2]; a.w_ada = (const float*)d_in[3]; a.b_ada = (const float*)d_in[4];
    a.g_mix = (const float*)d_in[5]; a.g_ffn = (const float*)d_in[6]; a.w_in = (const float*)d_in[7]; a.g_q = (const float*)d_in[8]; a.g_k = (const float*)d_in[9];
    a.g_kidx = (const float*)d_in[10]; a.w_pool = (const float*)d_in[11]; a.pool_scale = (const float*)d_in[12]; a.w_out = (const float*)d_in[13];
    a.w_rg = (const float*)d_in[14]; a.b_rg = (const float*)d_in[15]; a.w_re = (const float*)d_in[16]; a.b_re = (const float*)d_in[17];
    a.w_gate = (const float*)d_in[18]; a.w_up = (const float*)d_in[19]; a.w_down = (const float*)d_in[20];
    a.out = (float*)d_out; a.ws = (unsigned char*)d_ws;
#if N_LAUNCH_MODE == 1
    a.ph_lo = 0; a.ph_hi = NPH;
    hipLaunchKernelGGL(fwd, dim3(grid), dim3(512), LDS_BYTES, stream, a);
#else
    for (int p = 0; p < NPH; ++p) { a.ph_lo = p; a.ph_hi = p + 1; hipLaunchKernelGGL(fwd, dim3(grid), dim3(512), LDS_BYTES, stream, a); }
#endif
}
```
